# Optimizing an MI355X kernel written in HIP

```python
import jax, jax.numpy as jnp
from jax import lax
import numpy as np

D_MODEL = 2048
BATCH = 4
SEQ = 2048
DEPTH = 2

N_Q_HEADS = 16
N_KV_HEADS = 4
HEAD_DIM = 64
Q_PER_KV = N_Q_HEADS // N_KV_HEADS
NSA_WIDTH = N_Q_HEADS * HEAD_DIM
KV_WIDTH = N_KV_HEADS * HEAD_DIM
CMP_BLOCK = 32
CMP_STRIDE = 16
CMP_HIDDEN = 256
SLC_BLOCK = 64
N_SELECT = 16
SLC_QUERY_BLOCK = 64
WINDOW = 512
WIN_QUERY_BLOCK = 128
FORCED_SCORE = 1e4
SGU_WIDTH = D_MODEL // 2
SGU_GROUPS = 8
SGU_GROUP_DIM = SGU_WIDTH // SGU_GROUPS
SGU_CHUNK = 128
D_FF_DENSE = 256 * ((8 * D_MODEL // 3 + 255) // 256)
N_EXPERTS = 8
TOP_K = 2
D_FF_EXPERT = 7 * D_MODEL // 2
NORM_EPS = 1e-5

IN_SIZES = (NSA_WIDTH, KV_WIDTH, KV_WIDTH, KV_WIDTH, KV_WIDTH, KV_WIDTH, KV_WIDTH,
            3 * N_Q_HEADS, SGU_WIDTH, SGU_WIDTH, D_MODEL, D_MODEL)
IN_WIDTH = sum(IN_SIZES)

kernel_name = "hybrid_nsa_gmlp_moe_trunk"


def rms_norm(x, g):
    xf = x.astype(jnp.float32)
    y = xf * lax.rsqrt(jnp.mean(xf * xf, axis=-1, keepdims=True) + NORM_EPS)
    return (y * g.astype(jnp.float32)).astype(x.dtype)


def layer_norm(x, g, b):
    xf = x.astype(jnp.float32)
    mu = jnp.mean(xf, axis=-1, keepdims=True)
    var = jnp.mean(jnp.square(xf - mu), axis=-1, keepdims=True)
    y = (xf - mu) * lax.rsqrt(var + NORM_EPS)
    return (y * g.astype(jnp.float32) + b.astype(jnp.float32)).astype(x.dtype)


def masked_softmax(s, mask):
    s = jnp.where(mask, s.astype(jnp.float32), -jnp.inf)
    m = jnp.max(s, axis=-1, keepdims=True)
    m = jnp.where(jnp.isfinite(m), m, 0.0)
    e = jnp.where(mask, jnp.exp(s - m), 0.0)
    return e / jnp.maximum(jnp.sum(e, axis=-1, keepdims=True), 1e-30)


def alibi_slopes():
    sl = np.array([2.0 ** (-8.0 * (h + 1) / N_Q_HEADS) for h in range(N_Q_HEADS)], dtype=np.float32)
    return jnp.asarray(sl.reshape(N_KV_HEADS, Q_PER_KV))


def split_in(z):
    points = np.cumsum(np.array(IN_SIZES))[:-1].tolist()
    return jnp.split(z, points, axis=-1)


def cmp_to_slc_overlap(n_cmp, n_slc):
    cs = np.arange(n_cmp)[:, None] * CMP_STRIDE
    ss = np.arange(n_slc)[None, :] * SLC_BLOCK
    ov = np.clip(np.minimum(cs + CMP_BLOCK, ss + SLC_BLOCK) - np.maximum(cs, ss), 0, None)
    return jnp.asarray((ov / CMP_STRIDE).astype(np.float32))


def compress_blocks(kv, pe, w1, w2):
    B, T, G, dh = kv.shape
    r = CMP_BLOCK // CMP_STRIDE
    n_chunks = T // CMP_STRIDE
    n_cmp = n_chunks - r + 1
    chunks = kv.reshape(B, n_chunks, CMP_STRIDE, G, dh)
    blocks = jnp.concatenate([chunks[:, j:j + n_cmp] for j in range(r)], axis=2)
    blocks = blocks + pe[None, None, :, None, :]
    flat = blocks.transpose(0, 1, 3, 2, 4).reshape(B, n_cmp, G, CMP_BLOCK * dh)
    return jax.nn.gelu(flat @ w1) @ w2


def nsa_attention(q, k_cmp, v_cmp, k_slc, v_slc, k_win, v_win, gates, pe_k, pe_v, kw1, kw2, vw1, vw2):
    B, T, G, hg, dh = q.shape
    scale = dh ** -0.5
    slopes = alibi_slopes()
    t = jnp.arange(T)

    kc = compress_blocks(k_cmp, pe_k, kw1, kw2)
    vc = compress_blocks(v_cmp, pe_v, vw1, vw2)
    n_cmp = kc.shape[1]
    blk_end = jnp.arange(n_cmp) * CMP_STRIDE + (CMP_BLOCK - 1)
    dist_c = t[:, None] - blk_end[None, :]
    s_c = jnp.einsum('btgjd,bcgd->bgjtc', q, kc).astype(jnp.float32) * scale
    s_c = s_c - slopes[None, :, :, None, None] * dist_c.astype(jnp.float32)
    p_c = masked_softmax(s_c, dist_c >= 0)
    o_c = jnp.einsum('bgjtc,bcgd->btgjd', p_c.astype(vc.dtype), vc)

    n_slc = T // SLC_BLOCK
    overlap = cmp_to_slc_overlap(n_cmp, n_slc)
    imp = jnp.einsum('bgjtc,cn->bgtn', p_c, overlap)
    blk = jnp.arange(n_slc)
    cur = t // SLC_BLOCK
    valid = blk[None, :] * SLC_BLOCK <= t[:, None]
    forced = (blk[None, :] == 0) | (blk[None, :] == cur[:, None]) | (blk[None, :] == cur[:, None] - 1)
    score = jnp.where(valid, imp, -1.0)
    score = jnp.where(forced, FORCED_SCORE, score)
    n_top = min(N_SELECT, n_slc)
    _, idx = lax.top_k(score, n_top)

    k_blocks = k_slc.reshape(B, n_slc, SLC_BLOCK, G, dh).transpose(0, 3, 1, 2, 4)
    v_blocks = v_slc.reshape(B, n_slc, SLC_BLOCK, G, dh).transpose(0, 3, 1, 2, 4)
    QB = SLC_QUERY_BLOCK
    nq = T // QB
    q_b = q.reshape(B, nq, QB, G, hg, dh).transpose(1, 0, 3, 4, 2, 5)
    idx_b = idx.reshape(B, G, nq, QB, n_top).transpose(2, 0, 1, 3, 4)
    t_b = t.reshape(nq, QB)
    b_i = jnp.arange(B)[:, None, None, None]
    g_i = jnp.arange(G)[None, :, None, None]
    n_keys = n_top * SLC_BLOCK

    def slc_step(args):
        q_i, idx_i, t_i = args
        k_sel = k_blocks[b_i, g_i, idx_i].reshape(B, G, QB, n_keys, dh)
        v_sel = v_blocks[b_i, g_i, idx_i].reshape(B, G, QB, n_keys, dh)
        kpos = (idx_i[..., None] * SLC_BLOCK + jnp.arange(SLC_BLOCK)).reshape(B, G, QB, n_keys)
        dist = (t_i[None, None, :, None] - kpos)[:, :, None]
        s = jnp.einsum('bgjqd,bgqkd->bgjqk', q_i, k_sel).astype(jnp.float32) * scale
        s = s - slopes[None, :, :, None, None] * dist.astype(jnp.float32)
        p = masked_softmax(s, dist >= 0)
        return jnp.einsum('bgjqk,bgqkd->bgjqd', p.astype(v_sel.dtype), v_sel)

    o_s = lax.map(slc_step, (q_b, idx_b, t_b))
    o_s = o_s.transpose(1, 0, 4, 2, 3, 5).reshape(B, T, G, hg, dh)

    WQ = WIN_QUERY_BLOCK
    nw = T // WQ
    r = WINDOW // WQ
    n_band = (r + 1) * WQ
    k_pad = jnp.pad(k_win, ((0, 0), (WINDOW, 0), (0, 0), (0, 0))).reshape(B, nw + r, WQ, G, dh)
    v_pad = jnp.pad(v_win, ((0, 0), (WINDOW, 0), (0, 0), (0, 0))).reshape(B, nw + r, WQ, G, dh)
    k_band = jnp.concatenate([k_pad[:, j:j + nw] for j in range(r + 1)], axis=2)
    v_band = jnp.concatenate([v_pad[:, j:j + nw] for j in range(r + 1)], axis=2)
    q_w = q.reshape(B, nw, WQ, G, hg, dh)
    tq = t.reshape(nw, WQ)
    kpos_w = jnp.arange(nw)[:, None] * WQ - WINDOW + jnp.arange(n_band)[None, :]
    dist_w = tq[:, :, None] - kpos_w[:, None, :]
    mask_w = (dist_w >= 0) & (dist_w < WINDOW) & (kpos_w[:, None, :] >= 0)
    s_w = jnp.einsum('bnqgjd,bnkgd->bgjnqk', q_w, k_band).astype(jnp.float32) * scale
    s_w = s_w - slopes[None, :, :, None, None, None] * dist_w.astype(jnp.float32)
    p_w = masked_softmax(s_w, mask_w)
    o_w = jnp.einsum('bgjnqk,bnkgd->bnqgjd', p_w.astype(v_band.dtype), v_band).reshape(B, T, G, hg, dh)

    g = jax.nn.sigmoid(gates.astype(jnp.float32)).astype(q.dtype)
    o = g[..., 0:1] * o_c + g[..., 1:2] * o_s + g[..., 2:3] * o_w
    return o.reshape(B, T, G * hg * dh)


def spatial_gating(u, v, ln_g, ln_b, w_s, b_s):
    B, T, _ = u.shape
    u = jax.nn.gelu(u)
    v = layer_norm(jax.nn.gelu(v), ln_g, ln_b)
    vg = v.reshape(B, T // SGU_CHUNK, SGU_CHUNK, SGU_GROUPS, SGU_GROUP_DIM)
    w_causal = jnp.tril(w_s)
    vm = jnp.einsum('gts,bnsgd->bntgd', w_causal, vg) + b_s.T[None, None, :, :, None]
    return u * vm.reshape(B, T, SGU_WIDTH)


def hybrid_mixer(h, w_in, pe_k, pe_v, kw1, kw2, vw1, vw2, ln_g, ln_b, w_s, b_s, w_a, w_b, w_out):
    B, T, _ = h.shape
    z = h @ w_in
    (q, kc, vc, ks, vs, kw, vw, ng, u, v, ga, gb) = split_in(z)
    kv = lambda a: a.reshape(B, T, N_KV_HEADS, HEAD_DIM)
    o_a = nsa_attention(q.reshape(B, T, N_KV_HEADS, Q_PER_KV, HEAD_DIM),
                        kv(kc), kv(vc), kv(ks), kv(vs), kv(kw), kv(vw),
                        ng.reshape(B, T, N_KV_HEADS, Q_PER_KV, 3),
                        pe_k, pe_v, kw1, kw2, vw1, vw2)
    o_b = spatial_gating(u, v, ln_g, ln_b, w_s, b_s)
    gate_a = jax.nn.sigmoid(ga.astype(jnp.float32)).astype(h.dtype)
    gate_b = jax.nn.sigmoid(gb.astype(jnp.float32)).astype(h.dtype)
    y = gate_a * (o_a @ w_a) + gate_b * (o_b @ w_b)
    return y @ w_out


def swiglu(h, w1, w3, w2):
    return (jax.nn.silu(h @ w1) * (h @ w3)) @ w2


def moe_swiglu(h, router_w, router_b, w1, w3, w2):
    logits = (h @ router_w).astype(jnp.float32) + router_b.astype(jnp.float32)
    top_v, top_i = lax.top_k(logits, TOP_K)
    wts = jax.nn.softmax(top_v, axis=-1)
    out = jnp.zeros_like(h)
    for e in range(N_EXPERTS):
        gate_e = jnp.sum(jnp.where(top_i == e, wts, 0.0), axis=-1).astype(h.dtype)
        out = out + gate_e[..., None] * swiglu(h, w1[e], w3[e], w2[e])
    return out


def setup_inputs(seed: int = 0) -> dict:
    key = jax.random.key(seed)
    ks = iter(jax.random.split(key, 32))
    n_dense = (DEPTH + 1) // 2
    n_moe = DEPTH // 2
    f32 = jnp.float32

    def nrm(shape, scale):
        return jax.random.normal(next(ks), shape, f32) * scale

    def gain(shape):
        return 1.0 + 0.02 * jax.random.normal(next(ks), shape, f32)

    return {
        "x": jax.random.normal(next(ks), (BATCH, SEQ, D_MODEL), f32),
        "norm_mix": gain((DEPTH, D_MODEL)),
        "w_in": nrm((DEPTH, D_MODEL, IN_WIDTH), D_MODEL ** -0.5),
        "cmp_pe_k": nrm((DEPTH, CMP_BLOCK, HEAD_DIM), 0.02),
        "cmp_pe_v": nrm((DEPTH, CMP_BLOCK, HEAD_DIM), 0.02),
        "cmp_k_w1": nrm((DEPTH, CMP_BLOCK * HEAD_DIM, CMP_HIDDEN), (CMP_BLOCK * HEAD_DIM) ** -0.5),
        "cmp_k_w2": nrm((DEPTH, CMP_HIDDEN, HEAD_DIM), CMP_HIDDEN ** -0.5),
        "cmp_v_w1": nrm((DEPTH, CMP_BLOCK * HEAD_DIM, CMP_HIDDEN), (CMP_BLOCK * HEAD_DIM) ** -0.5),
        "cmp_v_w2": nrm((DEPTH, CMP_HIDDEN, HEAD_DIM), CMP_HIDDEN ** -0.5),
        "sgu_ln_g": gain((DEPTH, SGU_WIDTH)),
        "sgu_ln_b": nrm((DEPTH, SGU_WIDTH), 0.02),
        "sgu_w": nrm((DEPTH, SGU_GROUPS, SGU_CHUNK, SGU_CHUNK), SGU_CHUNK ** -0.5),
        "sgu_b": gain((DEPTH, SGU_GROUPS, SGU_CHUNK)),
        "w_branch_a": nrm((DEPTH, NSA_WIDTH, D_MODEL), NSA_WIDTH ** -0.5),
        "w_branch_b": nrm((DEPTH, SGU_WIDTH, D_MODEL), SGU_WIDTH ** -0.5),
        "w_out": nrm((DEPTH, D_MODEL, D_MODEL), D_MODEL ** -0.5),
        "norm_ffn": gain((DEPTH, D_MODEL)),
        "ffn_w1": nrm((n_dense, D_MODEL, D_FF_DENSE), D_MODEL ** -0.5),
        "ffn_w3": nrm((n_dense, D_MODEL, D_FF_DENSE), D_MODEL ** -0.5),
        "ffn_w2": nrm((n_dense, D_FF_DENSE, D_MODEL), D_FF_DENSE ** -0.5),
        "router_w": nrm((n_moe, D_MODEL, N_EXPERTS), D_MODEL ** -0.5),
        "router_b": nrm((n_moe, N_EXPERTS), 0.01),
        "moe_w1": nrm((n_moe, N_EXPERTS, D_MODEL, D_FF_EXPERT), D_MODEL ** -0.5),
        "moe_w3": nrm((n_moe, N_EXPERTS, D_MODEL, D_FF_EXPERT), D_MODEL ** -0.5),
        "moe_w2": nrm((n_moe, N_EXPERTS, D_FF_EXPERT, D_MODEL), D_FF_EXPERT ** -0.5),
        "norm_f": gain((D_MODEL,)),
    }


def reference(x, norm_mix, w_in, cmp_pe_k, cmp_pe_v, cmp_k_w1, cmp_k_w2, cmp_v_w1, cmp_v_w2,
              sgu_ln_g, sgu_ln_b, sgu_w, sgu_b, w_branch_a, w_branch_b, w_out, norm_ffn,
              ffn_w1, ffn_w3, ffn_w2, router_w, router_b, moe_w1, moe_w3, moe_w2, norm_f):
    for layer in range(DEPTH):
        h = rms_norm(x, norm_mix[layer])
        x = x + hybrid_mixer(h, w_in[layer], cmp_pe_k[layer], cmp_pe_v[layer],
                             cmp_k_w1[layer], cmp_k_w2[layer], cmp_v_w1[layer], cmp_v_w2[layer],
                             sgu_ln_g[layer], sgu_ln_b[layer], sgu_w[layer], sgu_b[layer],
                             w_branch_a[layer], w_branch_b[layer], w_out[layer])
        h = rms_norm(x, norm_ffn[layer])
        j = layer // 2
        if layer % 2 == 0:
            x = x + swiglu(h, ffn_w1[j], ffn_w3[j], ffn_w2[j])
        else:
            x = x + moe_swiglu(h, router_w[j], router_b[j], moe_w1[j], moe_w3[j], moe_w2[j])
    return rms_norm(x, norm_f)
```

```cpp
#include <hip/hip_runtime.h>
#include <cstdio>
#include <cstdint>

#ifndef MK_PER_PHASE
#define MK_PER_PHASE 0
#endif

#define GAS __attribute__((address_space(1)))
#define LAS __attribute__((address_space(3)))
typedef unsigned short bf16;
typedef unsigned short bf16_t;
typedef unsigned v4u __attribute__((ext_vector_type(4)));
typedef unsigned v2u __attribute__((ext_vector_type(2)));
typedef unsigned u32x4 __attribute__((ext_vector_type(4)));
typedef float f32x2 __attribute__((ext_vector_type(2)));
typedef float f32x4 __attribute__((ext_vector_type(4)));
typedef float f32x16 __attribute__((ext_vector_type(16)));
typedef short bf16x8 __attribute__((ext_vector_type(8)));

constexpr int NB = 4, T = 2048, M = NB * T, D = 2048;
constexpr int NHQ = 16, NG = 4, HD = 64;
constexpr int IN_W = 8752, ZLD = 8960;
constexpr int ZQ = 0, ZKS = 1536, ZVS = 1792, ZKW = 2048, ZVW = 2304, ZNG = 2560, ZU = 2816, ZV = 3840, ZGA = 4864, ZGB = 6912;
constexpr int FFD = 5632, FFE = 7168, NE = 8;
constexpr int MAXPT = 72;
constexpr float EPS = 1e-5f;
constexpr float LOG2E = 1.4426950408889634f;
constexpr float QSCALE = 0.125f * LOG2E;

constexpr size_t al256(size_t x) { return (x + 255) & ~(size_t)255; }
constexpr size_t WS_CTL = 0, CTL_BYTES = 1u << 20;
constexpr size_t WS_WIN = WS_CTL + CTL_BYTES;
constexpr size_t WS_CW1 = WS_WIN + (size_t)2 * ZLD * D * 2;
constexpr size_t WS_CW2 = WS_CW1 + (size_t)2 * 2 * 256 * 2048 * 2;
constexpr size_t WS_CB1 = WS_CW2 + (size_t)2 * 2 * 64 * 256 * 2;
constexpr size_t WS_WA = WS_CB1 + 4096;
constexpr size_t WS_WB = WS_WA + (size_t)2 * 2048 * 1024 * 2;
constexpr size_t WS_WO = WS_WB + (size_t)2 * 2048 * 1024 * 2;
constexpr size_t WS_SGW = WS_WO + (size_t)2 * 2048 * 2048 * 2;
constexpr size_t WS_FUP = WS_SGW + (size_t)2 * 8 * 128 * 128 * 2;
constexpr size_t WS_FDN = WS_FUP + (size_t)2 * FFD * D * 2;
constexpr size_t WS_MUP = WS_FDN + (size_t)D * FFD * 2;
constexpr size_t WS_MDN = WS_MUP + (size_t)NE * 2 * FFE * D * 2;
constexpr size_t WS_H = WS_MDN + (size_t)NE * D * FFE * 2;
constexpr size_t WS_XA = WS_H + (size_t)M * D * 2;
constexpr size_t WS_HPERM = WS_XA + (size_t)M * D * 4;
constexpr size_t WS_YPERM = WS_HPERM + (size_t)MAXPT * 256 * D * 2;
constexpr size_t WS_ROUTE = WS_YPERM + (size_t)MAXPT * 256 * D * 2;
constexpr size_t WS_KCT = WS_ROUTE + (1u << 20);
constexpr size_t WS_HID = WS_KCT + (size_t)2 * 16 * 128 * 64 * 2;
constexpr size_t WS_MIX = WS_HID + (size_t)4096 * 256 * 2;
constexpr size_t WS_Z = WS_MIX;
constexpr size_t WS_FLAT = WS_Z + (size_t)(M + 16) * ZLD * 2;
constexpr size_t WS_OA = WS_FLAT + (size_t)4096 * 2048 * 2;
constexpr size_t WS_OB = WS_OA + (size_t)M * 1024 * 2;
constexpr size_t WS_TMP = WS_OB + (size_t)M * 1024 * 2;
constexpr size_t WS_Y = WS_TMP + (size_t)M * D * 4;
constexpr size_t WS_MIX_END = WS_Y + (size_t)M * D * 2;
constexpr size_t WS_GBUF = WS_MIX;
constexpr size_t WS_GBUF_END = WS_GBUF + (size_t)MAXPT * 256 * FFE * 2;
constexpr size_t WS_END = WS_MIX_END > WS_GBUF_END ? WS_MIX_END : WS_GBUF_END;
constexpr size_t RT_TOKE = 0;
constexpr size_t RT_TOKW = 65536;
constexpr size_t RT_TOKP = 131072;
constexpr size_t RT_RGATE = 196608;
constexpr size_t RT_CNT = 294912;
constexpr size_t RT_TILEE = 327680;
constexpr int CW_BAR = 4096;

__device__ __forceinline__ unsigned f2bf(float f) { unsigned u = __builtin_bit_cast(unsigned, f); return (u + 0x7fffu + ((u >> 16) & 1u)) >> 16; }
__device__ __forceinline__ unsigned pk2(float lo, float hi) { return f2bf(lo) | (f2bf(hi) << 16); }
__device__ __forceinline__ float bf2f(unsigned short b) { return __builtin_bit_cast(float, ((unsigned)b) << 16); }
__device__ __forceinline__ float bflo(unsigned w) { return __builtin_bit_cast(float, w << 16); }
__device__ __forceinline__ float bfhi(unsigned w) { return __builtin_bit_cast(float, w & 0xffff0000u); }
typedef float f32x2_t __attribute__((ext_vector_type(2))); typedef __bf16 bf16x2_t __attribute__((ext_vector_type(2)));
__device__ __forceinline__ unsigned cvt_pk_bf16(float lo, float hi) { f32x2_t v = {lo, hi}; bf16x2_t b = __builtin_convertvector(v, bf16x2_t); return __builtin_bit_cast(unsigned, b); }
__device__ __forceinline__ float wave_sum(float v) {
#pragma unroll
    for (int o = 1; o < 64; o <<= 1) v += __shfl_xor(v, o);
    return v;
}
__device__ __forceinline__ float sigmoidf_(float x) { return __builtin_amdgcn_rcpf(1.0f + __builtin_amdgcn_exp2f(-LOG2E * x)); }
__device__ __forceinline__ float siluf_(float x) { return x * sigmoidf_(x); }
__device__ __forceinline__ float geluf_(float x) { return x * __builtin_amdgcn_rcpf(1.0f + __builtin_amdgcn_exp2f(-2.3022082f * (x + 0.044715f * x * x * x))); }
__device__ __forceinline__ int crow(int r, int hi) { return (r & 3) + 8 * (r >> 2) + 4 * hi; }
#define MFMA32(a, b, c) __builtin_amdgcn_mfma_f32_32x32x16_bf16((a), (b), (c), 0, 0, 0)

namespace pg8 {
constexpr int BM = 256, BK = 64, HALF = 128, HTB = HALF * BK * 2, STAGE_BYTES = 8 * HTB, NXCD = 8, WGM = 8;
__host__ __device__ __forceinline__ int lds_byte(int r, int c) { const int st = (r >> 4) * 2 + (c >> 5), rr = r & 15, cc = c & 31, ob = rr * 64 + cc * 2; return st * 1024 + (ob ^ (((ob >> 9) & 1) << 5)); }
__host__ __device__ __forceinline__ void stage_rc(int b, int& R, int& C) { const int st = b / 1024, sb = b % 1024, swz = sb ^ (((sb >> 9) & 1) << 5); R = (st >> 1) * 16 + swz / 64; C = (st & 1) * 32 + (swz % 64) / 2; }
__host__ __device__ __forceinline__ int perm32(int rho) { const int n = rho >> 4, i = rho & 15; return 8 * (i >> 2) + 4 * n + (i & 3); }

struct Unit { int pm, pn, be; };
struct Gemm { const bf16_t* A; const bf16_t* Bt; int M, N, K; size_t bstride; };

__device__ __forceinline__ void static_map(int wgid, int nM, int nN, int& pm, int& pn) {
    const int nwg = nM * nN;
    { const int q = nwg / NXCD, r = nwg % NXCD, xcd = wgid % NXCD, off = wgid / NXCD; wgid = (xcd < r ? xcd * (q + 1) : r * (q + 1) + (xcd - r) * q) + off; }
    const int nig = WGM * nN, gid = wgid / nig, fm = gid * WGM, gsz = (nM - fm) < WGM ? (nM - fm) : WGM;
    pm = fm + ((wgid % nig) % gsz); pn = (wgid % nig) / gsz;
}
struct StaticOrder {
    int nM, nN, nwg, G, c, be;
    __device__ void init(int M_, int N_, int G_, int c_, int be_ = 0) { nM = M_ / BM; nN = N_ / BM; nwg = nM * nN; G = G_; c = c_; be = be_; }
    __device__ bool next(int i, Unit& u) const {
        const long L = (long)i * G + c; if (L >= nwg) return false;
        static_map((int)L, nM, nN, u.pm, u.pn); u.be = be; return true;
    }
};
struct CmpOrder {
    int c;
    __device__ bool next(int i, Unit& u) const { if (i > 0 || c >= 16) return false; u.pm = c; u.pn = 0; u.be = c >> 3; return true; }
};
struct MoeOrder {
    int nM, nN, nwg, G, c; const int* tile_e;
    __device__ void init(int nM_, int N_, int G_, int c_, const int* te) { nM = nM_; nN = N_ / BM; nwg = nM * nN; G = G_; c = c_; tile_e = te; }
    __device__ bool next(int i, Unit& u) const {
        const long L = (long)i * G + c; if (L >= nwg) return false;
        static_map((int)L, nM, nN, u.pm, u.pn); u.be = __builtin_amdgcn_readfirstlane(tile_e[u.pm]); return true;
    }
};

struct MoeDownOrder {
    int nT, nV, nN, nwg, G, c; const int* tile_e;
    __device__ void init(int nT_, int N_, int G_, int c_, const int* te) { nT = nT_; nV = 2 * nT_; nN = N_ / BM; nwg = nV * nN; G = G_; c = c_; tile_e = te; }
    __device__ bool next(int i, Unit& u) const {
        const long L = (long)i * G + c; if (L >= nwg) return false;
        int v, pn; static_map((int)L, nV, nN, v, pn); const int h = v >= nT ? 1 : 0, t = v - h * nT;
        u.pm = h * MAXPT + t; u.pn = pn; u.be = __builtin_amdgcn_readfirstlane(tile_e[t]) * 2 + h; return true;
    }
};
template <class Epi, class Sched>
__device__ __forceinline__ void gemm_phase(LAS unsigned char* lds, const Gemm g, const Sched& S, const Epi& E, const int tid, unsigned* last_sig = nullptr) {
    const int wid = __builtin_amdgcn_readfirstlane(tid >> 6), lane = tid & 63, wr = wid >> 2, wc = wid & 3, fr = lane & 15, fq = lane >> 4;
    const int K = g.K, nt = K / BK;
    unsigned voffA[2], voffB[2];
#pragma unroll
    for (int i = 0; i < 2; ++i) { int R, C; stage_rc(tid * 16 + i * 8192, R, C); const int Rb = Epi::PERM ? ((R & ~31) + perm32(R & 31)) : R;
        voffA[i] = (unsigned)(R * K + C) * 2u; voffB[i] = (unsigned)(Rb * K + C) * 2u; }
    const size_t kstep = (size_t)(BK * 2);
    const size_t hstep = (size_t)HALF * K * 2;
    const size_t tstep = 2 * hstep;
    const unsigned ldsw = (unsigned)wid * 1024u;
    const int aoff = lds_byte(wr * 64 + fr, fq * 8), boff = lds_byte(wc * 32 + fr, fq * 8);
#define PG8_SA(b, h) (((b) * 2 + (h)) * HTB)
#define PG8_SB(b, h) ((4 + (b) * 2 + (h)) * HTB)
#define PG8_STAGE(bufoff, gbase, voff) do { _Pragma("unroll") for (int _i = 0; _i < 2; ++_i) \
        __builtin_amdgcn_global_load_lds((const unsigned*)((const char*)(gbase) + (voff)[_i]), (LAS unsigned*)(lds + (bufoff) + ldsw + _i * 8192), 16, 0, 0); } while (0)
#define PG8_LDA(dst, b, h) do { _Pragma("unroll") for (int m = 0; m < 4; ++m) _Pragma("unroll") for (int k = 0; k < 2; ++k) dst[m][k] = *(const LAS bf16x8*)(lds + PG8_SA(b, h) + aoff + m * 2048 + k * 1024); } while (0)
#define PG8_LDB(dst, b, h) do { _Pragma("unroll") for (int n = 0; n < 2; ++n) _Pragma("unroll") for (int k = 0; k < 2; ++k) dst[n][k] = *(const LAS bf16x8*)(lds + PG8_SB(b, h) + boff + n * 2048 + k * 1024); } while (0)
#define PG8_MMA(ai, bj, At, Bt) do { __builtin_amdgcn_s_setprio(1); _Pragma("unroll") for (int m = 0; m < 4; ++m) _Pragma("unroll") for (int n = 0; n < 2; ++n) _Pragma("unroll") for (int k = 0; k < 2; ++k) \
        acc[ai][bj][m][n] = __builtin_amdgcn_mfma_f32_16x16x32_bf16(Bt[n][k], At[m][k], acc[ai][bj][m][n], 0, 0, 0); __builtin_amdgcn_s_setprio(0); } while (0)
#define PG8_WAIT_V(n) asm volatile("s_waitcnt vmcnt(" #n ")" ::: "memory")
#define PG8_WAIT_L(n) asm volatile("s_waitcnt lgkmcnt(" #n ")" ::: "memory")
#define PG8_BAR __builtin_amdgcn_s_barrier()
#define PG8_SCHED __builtin_amdgcn_sched_barrier(0)
    Unit cur, nxt; int ui = 0;
    if (!S.next(0, cur)) return;
    f32x4 acc[2][2][4][2];
#pragma unroll
    for (int a = 0; a < 2; ++a)
#pragma unroll
        for (int b = 0; b < 2; ++b)
#pragma unroll
            for (int m = 0; m < 4; ++m)
#pragma unroll
                for (int n = 0; n < 2; ++n) acc[a][b][m][n] = (f32x4){0.f, 0.f, 0.f, 0.f};
    bf16x8 At[4][2], B0[2][2], B1[2][2];
    const char* cA = (const char*)g.A + (size_t)cur.pm * tstep; const char* cB = (const char*)g.Bt + (size_t)cur.be * g.bstride + (size_t)cur.pn * tstep;
    PG8_STAGE(PG8_SB(0, 0), cB, voffB); PG8_STAGE(PG8_SB(0, 1), cB + hstep, voffB); PG8_STAGE(PG8_SA(0, 0), cA, voffA); PG8_STAGE(PG8_SA(0, 1), cA + hstep, voffA);
    if (wr == 1) PG8_BAR;
    PG8_WAIT_V(2); PG8_BAR;
    PG8_STAGE(PG8_SB(1, 0), cB + kstep, voffB); PG8_STAGE(PG8_SA(1, 0), cA + kstep, voffA); PG8_STAGE(PG8_SB(1, 1), cB + hstep + kstep, voffB);
    PG8_WAIT_V(6); PG8_BAR;
    for (;;) {
        const bool has_next = S.next(ui + 1, nxt);
        if (last_sig != nullptr && !has_next && wid == 0 && __builtin_amdgcn_mbcnt_hi(~0u, __builtin_amdgcn_mbcnt_lo(~0u, 0u)) == 0u) (void)__hip_atomic_fetch_add(last_sig, 1u, __ATOMIC_RELAXED, __HIP_MEMORY_SCOPE_AGENT);
        const char* nA = has_next ? (const char*)g.A + (size_t)nxt.pm * tstep : cA; const char* nB = has_next ? (const char*)g.Bt + (size_t)nxt.be * g.bstride + (size_t)nxt.pn * tstep : cB;
        for (int t = 0; t < nt; t += 2) {
            const bool last = (t == nt - 2);
            const char* a1 = cA + (size_t)(t + 1) * kstep;
            const char* a2 = last ? nA : cA + (size_t)(t + 2) * kstep; const char* b2 = last ? nB : cB + (size_t)(t + 2) * kstep;
            const char* a3 = a2 + kstep; const char* b3 = b2 + kstep;
            PG8_LDB(B0, 0, 0); PG8_LDB(B1, 0, 1); PG8_SCHED; PG8_LDA(At, 0, 0); PG8_STAGE(PG8_SA(1, 1), a1 + hstep, voffA);
            PG8_WAIT_V(8); PG8_WAIT_L(0); PG8_BAR; PG8_MMA(0, 0, At, B0); PG8_MMA(0, 1, At, B1); PG8_BAR; PG8_SCHED;
            PG8_LDA(At, 0, 1); PG8_STAGE(PG8_SB(0, 0), b2, voffB); PG8_STAGE(PG8_SB(0, 1), b2 + hstep, voffB); PG8_STAGE(PG8_SA(0, 0), a2, voffA);
            PG8_WAIT_V(8); PG8_WAIT_L(0); PG8_BAR; PG8_MMA(1, 0, At, B0); PG8_MMA(1, 1, At, B1); PG8_BAR; PG8_SCHED;
            PG8_LDB(B0, 1, 0); PG8_LDB(B1, 1, 1); PG8_SCHED; PG8_LDA(At, 1, 0); PG8_STAGE(PG8_SA(0, 1), a2 + hstep, voffA);
            PG8_WAIT_V(8); PG8_WAIT_L(0); PG8_BAR; PG8_MMA(0, 0, At, B0); PG8_MMA(0, 1, At, B1); PG8_BAR; PG8_SCHED;
            PG8_LDA(At, 1, 1); PG8_STAGE(PG8_SB(1, 0), b3, voffB); PG8_STAGE(PG8_SB(1, 1), b3 + hstep, voffB); PG8_STAGE(PG8_SA(1, 0), a3, voffA);
            PG8_WAIT_V(8); PG8_WAIT_L(0); PG8_BAR; PG8_MMA(1, 0, At, B0); PG8_MMA(1, 1, At, B1); PG8_BAR; PG8_SCHED;
        }
        if (wr == 0) PG8_BAR;
        E(acc, cur, wr, wc, fr, fq);
        if (!has_next) break;
#pragma unroll
        for (int a = 0; a < 2; ++a)
#pragma unroll
            for (int b = 0; b < 2; ++b)
#pragma unroll
                for (int m = 0; m < 4; ++m)
#pragma unroll
                    for (int n = 0; n < 2; ++n) acc[a][b][m][n] = (f32x4){0.f, 0.f, 0.f, 0.f};
        cur = nxt; cA = nA; cB = nB; ++ui;
        if (wr == 1) PG8_BAR;
    }
    PG8_WAIT_V(0);
    PG8_BAR;
#undef PG8_SA
#undef PG8_SB
#undef PG8_STAGE
#undef PG8_LDA
#undef PG8_LDB
#undef PG8_MMA
#undef PG8_WAIT_V
#undef PG8_WAIT_L
#undef PG8_BAR
#undef PG8_SCHED
}

struct EpiWin {
    static constexpr bool PERM = true;
    bf16_t* Z; bf16_t* flat;
    template <int KIND> __device__ __forceinline__ void run(const f32x4 (&acc)[2][2][4][2], const Unit& u, int wr, int wc, int fr, int fq) const {
        const int row0 = u.pm * BM + wr * 64 + fr, colin = wc * 32 + 8 * fq;
#pragma unroll
        for (int ai = 0; ai < 2; ++ai)
#pragma unroll
            for (int m = 0; m < 4; ++m) { const int row = row0 + ai * HALF + m * 16;
#pragma unroll
                for (int bj = 0; bj < 2; ++bj) { f32x4 v0 = acc[ai][bj][m][0], v1 = acc[ai][bj][m][1];
                    if (KIND == 1) { v0 = v0 * QSCALE; v1 = v1 * QSCALE; }
                    if (KIND == 2) {
#pragma unroll
                        for (int j = 0; j < 4; ++j) { v0[j] = geluf_(v0[j]); v1[j] = geluf_(v1[j]); } }
                    if (KIND == 3) {
#pragma unroll
                        for (int j = 0; j < 4; ++j) { v0[j] = sigmoidf_(v0[j]); v1[j] = sigmoidf_(v1[j]); } }
                    u32x4 w; w.x = cvt_pk_bf16(v0[0], v0[1]); w.y = cvt_pk_bf16(v0[2], v0[3]); w.z = cvt_pk_bf16(v1[0], v1[1]); w.w = cvt_pk_bf16(v1[2], v1[3]);
                    const int cc = bj * HALF + colin;
                    if (KIND == 4) {
                        const int b = row >> 11, tt = row & 2047, j = tt >> 4, pp = tt & 15, gg = cc >> 6, d = cc & 63;
                        bf16_t* fl = flat + (size_t)(u.pn - 4) * 2048 * 2048;
                        *(u32x4*)(fl + (size_t)((b * 128 + j) * 4 + gg) * 2048 + pp * 64 + d) = w;
                        if (j >= 1) *(u32x4*)(fl + (size_t)((b * 128 + j - 1) * 4 + gg) * 2048 + (16 + pp) * 64 + d) = w;
                    } else {
                        *(u32x4*)(Z + (size_t)row * ZLD + u.pn * BM + cc) = w;
                    } } }
    }
    __device__ __forceinline__ void operator()(const f32x4 (&acc)[2][2][4][2], const Unit& u, int wr, int wc, int fr, int fq) const {
        const int pn = u.pn;
        if (pn < 4) run<1>(acc, u, wr, wc, fr, fq);
        else if (pn < 6) run<4>(acc, u, wr, wc, fr, fq);
        else if (pn < 11) run<0>(acc, u, wr, wc, fr, fq);
        else if (pn < 19) run<2>(acc, u, wr, wc, fr, fq);
        else run<3>(acc, u, wr, wc, fr, fq);
    }
};
struct EpiCmp {
    static constexpr bool PERM = true;
    bf16_t* O; const float* bias;
    __device__ __forceinline__ void operator()(const f32x4 (&acc)[2][2][4][2], const Unit& u, int wr, int wc, int fr, int fq) const {
        const int row0 = u.pm * BM + wr * 64 + fr, colin = wc * 32 + 8 * fq;
        f32x4 bv[2][2];
#pragma unroll
        for (int bj = 0; bj < 2; ++bj)
#pragma unroll
            for (int n = 0; n < 2; ++n) bv[bj][n] = *(const f32x4*)(bias + u.be * 256 + colin + bj * HALF + 4 * n);
#pragma unroll
        for (int ai = 0; ai < 2; ++ai)
#pragma unroll
            for (int m = 0; m < 4; ++m) { bf16_t* rowp = O + (size_t)(row0 + ai * HALF + m * 16) * 256 + colin;
#pragma unroll
                for (int bj = 0; bj < 2; ++bj) { f32x4 v0 = acc[ai][bj][m][0] + bv[bj][0], v1 = acc[ai][bj][m][1] + bv[bj][1];
#pragma unroll
                    for (int j = 0; j < 4; ++j) { v0[j] = geluf_(v0[j]); v1[j] = geluf_(v1[j]); }
                    u32x4 w; w.x = cvt_pk_bf16(v0[0], v0[1]); w.y = cvt_pk_bf16(v0[2], v0[3]); w.z = cvt_pk_bf16(v1[0], v1[1]); w.w = cvt_pk_bf16(v1[2], v1[3]);
                    *(u32x4*)(rowp + bj * HALF) = w; } }
    }
};
struct EpiGate {
    static constexpr bool PERM = true;
    const bf16_t* Z; bf16_t* tmp; bf16_t* Y;
    __device__ __forceinline__ void operator()(const f32x4 (&acc)[2][2][4][2], const Unit& u, int wr, int wc, int fr, int fq) const {
        const int row0 = u.pm * BM + wr * 64 + fr, col0 = u.pn * BM + wc * 32 + 8 * fq;
        const int goff = u.be ? ZGB : ZGA;
#pragma unroll
        for (int ai = 0; ai < 2; ++ai) {
            u32x4 gq[4][2], tq[4][2];
#pragma unroll
            for (int m = 0; m < 4; ++m) { const size_t row = (size_t)(row0 + ai * HALF + m * 16);
#pragma unroll
                for (int bj = 0; bj < 2; ++bj) { const int c = col0 + bj * HALF;
                    gq[m][bj] = *(const u32x4*)(Z + row * ZLD + goff + c);
                    if (u.be != 0) tq[m][bj] = *(const u32x4*)(tmp + row * D + c); } }
#pragma unroll
            for (int m = 0; m < 4; ++m) { const size_t row = (size_t)(row0 + ai * HALF + m * 16);
#pragma unroll
                for (int bj = 0; bj < 2; ++bj) { const int c = col0 + bj * HALF; const u32x4 g = gq[m][bj];
                    f32x4 v0 = acc[ai][bj][m][0] * (f32x4){bflo(g.x), bfhi(g.x), bflo(g.y), bfhi(g.y)};
                    f32x4 v1 = acc[ai][bj][m][1] * (f32x4){bflo(g.z), bfhi(g.z), bflo(g.w), bfhi(g.w)};
                    if (u.be != 0) { const u32x4 t = tq[m][bj];
                        v0 = v0 + (f32x4){bflo(t.x), bfhi(t.x), bflo(t.y), bfhi(t.y)}; v1 = v1 + (f32x4){bflo(t.z), bfhi(t.z), bflo(t.w), bfhi(t.w)}; }
                    u32x4 w; w.x = cvt_pk_bf16(v0[0], v0[1]); w.y = cvt_pk_bf16(v0[2], v0[3]); w.z = cvt_pk_bf16(v1[0], v1[1]); w.w = cvt_pk_bf16(v1[2], v1[3]);
                    *(u32x4*)((u.be != 0 ? Y : tmp) + row * D + c) = w; } }
        }
    }
};
struct EpiResid {
    static constexpr bool PERM = false;
    const float* base; float* out;
    __device__ __forceinline__ void operator()(const f32x4 (&acc)[2][2][4][2], const Unit& u, int wr, int wc, int fr, int fq) const {
        const int row0 = u.pm * BM + wr * 64 + fr, col0 = u.pn * BM + wc * 32 + 4 * fq;
#pragma unroll
        for (int ai = 0; ai < 2; ++ai) {
            f32x4 bs[4][2][2];
#pragma unroll
            for (int m = 0; m < 4; ++m) { const size_t off = (size_t)(row0 + ai * HALF + m * 16) * D + col0;
#pragma unroll
                for (int bj = 0; bj < 2; ++bj)
#pragma unroll
                    for (int n = 0; n < 2; ++n) bs[m][bj][n] = *(const f32x4*)(base + off + bj * HALF + n * 16); }
#pragma unroll
            for (int m = 0; m < 4; ++m) { const size_t off = (size_t)(row0 + ai * HALF + m * 16) * D + col0;
#pragma unroll
                for (int bj = 0; bj < 2; ++bj)
#pragma unroll
                    for (int n = 0; n < 2; ++n) *(f32x4*)(out + off + bj * HALF + n * 16) = bs[m][bj][n] + acc[ai][bj][m][n]; }
        }
    }
};
struct EpiSwiglu {
    static constexpr bool PERM = true;
    bf16_t* Gb; int ldg; int half_tiles; size_t half_stride;
    __device__ __forceinline__ void operator()(const f32x4 (&acc)[2][2][4][2], const Unit& u, int wr, int wc, int fr, int fq) const {
        const int hsel = (half_tiles > 0 && u.pn >= half_tiles) ? 1 : 0;
        const int row0 = u.pm * BM + wr * 64 + fr, col0 = (u.pn - hsel * half_tiles) * HALF + wc * 32 + 8 * fq;
        bf16_t* const Gh = Gb + (size_t)hsel * half_stride;
#pragma unroll
        for (int ai = 0; ai < 2; ++ai)
#pragma unroll
            for (int m = 0; m < 4; ++m) { bf16_t* rowp = Gh + (size_t)(row0 + ai * HALF + m * 16) * ldg + col0;
                f32x4 a0 = acc[ai][0][m][0], a1 = acc[ai][0][m][1]; const f32x4 b0 = acc[ai][1][m][0], b1 = acc[ai][1][m][1];
#pragma unroll
                for (int j = 0; j < 4; ++j) { a0[j] = siluf_(a0[j]) * b0[j]; a1[j] = siluf_(a1[j]) * b1[j]; }
                u32x4 w; w.x = cvt_pk_bf16(a0[0], a0[1]); w.y = cvt_pk_bf16(a0[2], a0[3]); w.z = cvt_pk_bf16(a1[0], a1[1]); w.w = cvt_pk_bf16(a1[2], a1[3]);
                *(u32x4*)rowp = w; }
    }
};
struct EpiMoeDown {
    static constexpr bool PERM = true;
    bf16_t* Y0; bf16_t* Y1;
    __device__ __forceinline__ void operator()(const f32x4 (&acc)[2][2][4][2], const Unit& u, int wr, int wc, int fr, int fq) const {
        const int hsel = u.pm >= MAXPT ? 1 : 0; bf16_t* const Y = hsel ? Y1 : Y0;
        const int row0 = (u.pm - hsel * MAXPT) * BM + wr * 64 + fr, col0 = u.pn * BM + wc * 32 + 8 * fq;
#pragma unroll
        for (int ai = 0; ai < 2; ++ai)
#pragma unroll
            for (int m = 0; m < 4; ++m) { const int row = row0 + ai * HALF + m * 16; bf16_t* rowp = Y + (size_t)row * D + col0;
#pragma unroll
                for (int bj = 0; bj < 2; ++bj) { const f32x4 v0 = acc[ai][bj][m][0], v1 = acc[ai][bj][m][1];
                    u32x4 w; w.x = cvt_pk_bf16(v0[0], v0[1]); w.y = cvt_pk_bf16(v0[2], v0[3]); w.z = cvt_pk_bf16(v1[0], v1[1]); w.w = cvt_pk_bf16(v1[2], v1[3]);
                    *(u32x4*)(rowp + bj * HALF) = w; } }
    }
};
}

#define XB_TMO      128
#define XB_XCNT(j)  (256  + 64 * (j))
#define XB_XSUB(j)  (1280 + 64 * (j))
#define XB_XGEN(j)  (2304 + 64 * (j))
#define XB_TOP      3328
#define XB_TOPGEN   3392
#define XCD_BAR_WORDS 3456
#define XB_SPIN_CAP (1u << 18)
__device__ __forceinline__ unsigned xb_ld(unsigned* p)              { return __hip_atomic_load(p, __ATOMIC_RELAXED, __HIP_MEMORY_SCOPE_AGENT); }
__device__ __forceinline__ unsigned xb_add(unsigned* p, unsigned v) { return __hip_atomic_fetch_add(p, v, __ATOMIC_RELAXED, __HIP_MEMORY_SCOPE_AGENT); }
__device__ __forceinline__ unsigned xb_xcc_id() { return (unsigned)__builtin_amdgcn_s_getreg((3 << 11) | 20) & 0xFu; }
#define XB_SPIN(cond, bar) do { unsigned _sp = 0; while (cond) { __builtin_amdgcn_s_sleep(1); \
    if ((++_sp & 255u) == 0u) { if (xb_ld(&(bar)[XB_TMO])) break; if (_sp > XB_SPIN_CAP) { atomicAdd(&(bar)[XB_TMO], 1u); break; } } } } while (0)
struct XcdBarrier { unsigned* bar; unsigned x; volatile LAS unsigned* st; };
__device__ __forceinline__ XcdBarrier xcd_barrier_post(unsigned* bar, volatile LAS unsigned* st) {
    XcdBarrier b; b.bar = bar; b.x = xb_xcc_id(); b.st = st;
    if (threadIdx.x == 0) (void)xb_add(&bar[XB_XCNT(b.x)], 1u);
    return b;
}
__device__ __forceinline__ void xcd_barrier_complete(unsigned* bar, unsigned x, unsigned& nloc, unsigned& nx) {
    const unsigned G = gridDim.x * gridDim.y * gridDim.z;
    unsigned sum, cnt, mine, sp = 0u;
    for (;;) {
        sum = 0u; cnt = 0u; mine = 0u;
#pragma unroll
        for (unsigned j = 0; j < 16; ++j) { const unsigned c = xb_ld(&bar[XB_XCNT(j)]); sum += c; cnt += (c > 0u) ? 1u : 0u; mine = (j == x) ? c : mine; }
        if (sum == G) break;
        __builtin_amdgcn_s_sleep(1);
        if ((++sp & 255u) == 0u) { if (xb_ld(&bar[XB_TMO])) break; if (sp > XB_SPIN_CAP) { atomicAdd(&bar[XB_TMO], 1u); break; } }
    }
    nloc = mine > 0u ? mine : 1u; nx = cnt > 0u ? cnt : 1u;
}
__device__ __forceinline__ void xcd_barrier(const XcdBarrier& b) {
    asm volatile("s_waitcnt vmcnt(0)" ::: "memory");
    __syncthreads();
    if (threadIdx.x == 0) {
        unsigned* bar = b.bar;
        __builtin_amdgcn_s_waitcnt(0);
        unsigned nloc = b.st[0], nx = b.st[1];
        if (nloc == 0u) { xcd_barrier_complete(bar, b.x, nloc, nx); b.st[0] = nloc; b.st[1] = nx; }
        const unsigned old = xb_add(&bar[XB_XSUB(b.x)], 1u);
        const unsigned gen = old / nloc;
        if (old + 1u == (gen + 1u) * nloc) {
            __builtin_amdgcn_fence(__ATOMIC_RELEASE, "agent");
            asm volatile("s_waitcnt vmcnt(0)" ::: "memory");
            const unsigned og = xb_add(&bar[XB_TOP], 1u);
            const unsigned tg = og / nx;
            if (og + 1u == (tg + 1u) * nx) xb_add(&bar[XB_TOPGEN], 1u);
            else XB_SPIN(xb_ld(&bar[XB_TOPGEN]) == tg, bar);
            __builtin_amdgcn_fence(__ATOMIC_ACQUIRE, "agent");
            xb_add(&bar[XB_XGEN(b.x)], 1u);
            asm volatile("s_waitcnt vmcnt(0)" ::: "memory");
        } else {
            XB_SPIN(xb_ld(&bar[XB_XGEN(b.x)]) == gen, bar);
            __builtin_amdgcn_fence(__ATOMIC_ACQUIRE, "agent");
            asm volatile("s_waitcnt vmcnt(0)" ::: "memory");
        }
    }
    __syncthreads();
}

struct Args {
    const float* in[26];
    float* out; unsigned char* ws;
    int ph_lo, ph_hi;
};
enum { I_X = 0, I_NMIX, I_WIN, I_PEK, I_PEV, I_KW1, I_KW2, I_VW1, I_VW2, I_LNG, I_LNB, I_SGW, I_SGB, I_WA, I_WB, I_WO, I_NFFN, I_F1, I_F3, I_F2, I_RW, I_RB, I_M1, I_M3, I_M2, I_NF };

constexpr int NWAVES = 8;
constexpr int LDS_BYTES = 147456;
constexpr int LDS_MISC = 131072;

__device__ __forceinline__ void conv_item(const float* W, size_t ldw, int scol0, int nvalid, bf16* WT, int K, int drow0, int k0, LAS float* scr, int lane) {
    const int nl = lane & 31; const bool ok = nl < nvalid;
#pragma unroll 8
    for (int i = 0; i < 32; ++i) { const int kk = 2 * i + (lane >> 5); scr[kk * 33 + nl] = ok ? W[(size_t)(k0 + kk) * ldw + scol0 + nl] : 0.f; }
    asm volatile("s_waitcnt lgkmcnt(0)" ::: "memory");
    const int c = lane & 7;
#pragma unroll
    for (int j = 0; j < 4; ++j) { const int n = (lane >> 3) + 8 * j; const LAS float* s = scr + (8 * c) * 33 + n;
        v4u o; o.x = pk2(s[0 * 33], s[1 * 33]); o.y = pk2(s[2 * 33], s[3 * 33]); o.z = pk2(s[4 * 33], s[5 * 33]); o.w = pk2(s[6 * 33], s[7 * 33]);
        *(v4u*)(WT + (size_t)(drow0 + n) * K + k0 + 8 * c) = o; }
    asm volatile("s_waitcnt lgkmcnt(0)" ::: "memory");
}
__device__ __forceinline__ void conv_plain(const float* W, size_t ldw, int K, int N, bf16* WT, LAS float* scr, int gw, int ngw, int lane) {
    const int nblk = N / 32, items = (K / 64) * nblk;
    for (int it = gw; it < items; it += ngw) { const int kb = it / nblk, nb = it % nblk; conv_item(W, ldw, nb * 32, 32, WT, K, nb * 32, kb * 64, scr, lane); }
}
__device__ __forceinline__ void conv_win(const float* W, bf16* WT, LAS float* scr, int gw, int ngw, int lane) {
    const int nblk = ZLD / 32, items = (D / 64) * nblk;
    for (int it = gw; it < items; it += ngw) { const int kb = it / nblk, nb = it % nblk, d0 = nb * 32;
        int scol, nv; if (d0 + 32 <= 2608) { scol = d0; nv = 32; } else if (d0 < 2608) { scol = d0; nv = 2608 - d0; } else if (d0 < 2816) { scol = 0; nv = 0; } else { scol = d0 - 208; nv = 32; }
        conv_item(W, IN_W, scol, nv, WT, D, d0, kb * 64, scr, lane); }
}
__device__ __forceinline__ void conv_up(const float* W1, const float* W3, int F, bf16* WT, LAS float* scr, int gw, int ngw, int lane) {
    const int nblk = 2 * F / 32, items = (D / 64) * nblk;
    for (int it = gw; it < items; it += ngw) { const int kb = it / nblk, nb = it % nblk, d0 = nb * 32, pn = d0 >> 8, within = d0 & 255;
        const float* W = within < 128 ? W1 : W3; const int scol = pn * 128 + (within & 127);
        conv_item(W, F, scol, 32, WT, D, d0, kb * 64, scr, lane); }
}

__device__ __forceinline__ void conv_tile(const float* W, int ldw, int K, int N, bf16* WT, int rowmode, int kb, int nb, int lane, int sb0 = 0, int sb1 = 8) {
    const int c = lane & 7, nn = lane >> 3;
    const float* src0 = W + (size_t)(kb * 64 + 8 * c) * ldw;
#pragma unroll 2
    for (int sb = sb0; sb < sb1; ++sb) {
        const int n = nb * 256 + sb * 32 + 4 * nn;
        if (n < N) {
            int r = n;
            if (rowmode == 1) r = n < 2608 ? n : n + 208;
            else if (rowmode == 2) r = ((n >> 7) << 8) + (n & 127);
            else if (rowmode == 3) r = ((n >> 7) << 8) + 128 + (n & 127);
            const float* src = src0 + n;
            f32x4 v[8];
#pragma unroll
            for (int i = 0; i < 8; ++i) v[i] = *(const f32x4*)(src + (size_t)i * ldw);
            bf16* d0 = WT + (size_t)r * K + kb * 64 + 8 * c;
#pragma unroll
            for (int j = 0; j < 4; ++j) { u32x4 o; o.x = cvt_pk_bf16(v[0][j], v[1][j]); o.y = cvt_pk_bf16(v[2][j], v[3][j]); o.z = cvt_pk_bf16(v[4][j], v[5][j]); o.w = cvt_pk_bf16(v[6][j], v[7][j]);
                *(u32x4*)(d0 + (size_t)j * K) = o; }
        }
    }
}
constexpr int CQ_M13 = 8 * 2 * 32 * 7, CQ_M2 = 8 * 112 * 2;
constexpr int CW_Q = 8192;
#define CW_DONE(i) (CW_Q + 64 + 32 * (i))
constexpr unsigned CQ_END = 0xFFFFFFFFu;
__device__ __forceinline__ void conv_span128(const float* W, int ldw, int K, bf16* WT, int rowmode, int kb, int n0, int lane) {
    const int c = lane & 7, nn = lane >> 3;
    const float* src = W + (size_t)(kb * 64 + 8 * c) * ldw + n0 + 4 * nn;
    f32x4 v[4][8];
#pragma unroll
    for (int h = 0; h < 4; ++h)
#pragma unroll
        for (int i = 0; i < 8; ++i) v[h][i] = __builtin_nontemporal_load((const f32x4*)(src + 32 * h + (size_t)i * ldw));
#pragma unroll
    for (int h = 0; h < 4; ++h) {
        const int n = n0 + 32 * h + 4 * nn; int r = n;
        if (rowmode == 2) r = ((n >> 7) << 8) + (n & 127);
        else if (rowmode == 3) r = ((n >> 7) << 8) + 128 + (n & 127);
        bf16* d0 = WT + (size_t)r * K + kb * 64 + 8 * c;
#pragma unroll
        for (int j = 0; j < 4; ++j) { u32x4 o; o.x = cvt_pk_bf16(v[h][0][j], v[h][1][j]); o.y = cvt_pk_bf16(v[h][2][j], v[h][3][j]); o.z = cvt_pk_bf16(v[h][4][j], v[h][5][j]); o.w = cvt_pk_bf16(v[h][6][j], v[h][7][j]);
            *(u32x4*)(d0 + (size_t)j * K) = o; }
    }
}
__device__ __forceinline__ void signal_done(unsigned* p, int wave) { if (wave == 0 && __builtin_amdgcn_mbcnt_hi(~0u, __builtin_amdgcn_mbcnt_lo(~0u, 0u)) == 0u) xb_add(p, 1u); }
__device__ __forceinline__ unsigned convq_take(unsigned* ctl, bool allow2) {
    unsigned it = xb_add(ctl + CW_Q, 1u); if (it < (unsigned)CQ_M13) return it;
    if (allow2) { it = xb_add(ctl + CW_Q + 32, 1u); if (it < (unsigned)CQ_M2) return 0x80000000u | it; }
    return CQ_END;
}
__device__ __forceinline__ void conv_run(const float* m1, const float* m3, const float* m2, bf16* mup, bf16* mdn, unsigned* ctl, volatile LAS unsigned* bc, bool allow2, unsigned* done, unsigned target, int quota, int extra = 0) {
    int tid = threadIdx.x; asm volatile("" : "+v"(tid)); const int lane = tid & 63, wave = __builtin_amdgcn_readfirstlane(tid >> 6);
    unsigned nxt = CQ_END; int left = quota;
    if (tid == 0) { if (done != nullptr && left > extra && xb_ld(done) >= target) left = extra; nxt = left <= 0 ? CQ_END : convq_take(ctl, allow2); --left; }
    int par = 0;
#pragma unroll 1
    for (;;) {
        if (tid == 0) bc[par] = nxt;
        __syncthreads();
        const unsigned cur = __builtin_amdgcn_readfirstlane(bc[par]); par ^= 2;
        if (cur == CQ_END) break;
        if (tid == 0) { if (done != nullptr && left > extra && xb_ld(done) >= target) left = extra; nxt = left <= 0 ? CQ_END : convq_take(ctl, allow2); --left; }
        const int p = (int)(cur & 0x7FFFFFFFu);
        if ((cur >> 31) == 0u) { const int e = p / 448, w3 = (p / 224) & 1, q = p % 224;
            conv_span128((w3 ? m3 : m1) + (size_t)e * D * FFE, FFE, D, mup + (size_t)e * 2 * FFE * D, 2 + w3, q / 7, (q % 7) * 1024 + wave * 128, lane); }
        else { const int e = p / 224, q = p % 224, kb = q >> 1, h = kb / 56;
            conv_span128(m2 + (size_t)e * FFE * D + (size_t)h * (FFE / 2) * D, 2048, FFE / 2, mdn + (size_t)(e * 2 + h) * D * (FFE / 2), 0, kb - 56 * h, (q & 1) * 1024 + wave * 128, lane); }
    }
}
__device__ __forceinline__ float rms_row_load(const float* xrow, int lane, f32x4 (&v)[8]) {
    const f32x4* xr = (const f32x4*)xrow + lane; float s = 0.f;
#pragma unroll
    for (int j = 0; j < 8; ++j) { v[j] = xr[64 * j]; s += (v[j].x * v[j].x + v[j].y * v[j].y) + (v[j].z * v[j].z + v[j].w * v[j].w); }
    return 1.0f / sqrtf(wave_sum(s) * (1.0f / D) + EPS);
}
__device__ __forceinline__ void rms_row_to_bf16(const float* xrow, const float* gain, bf16* orow, int lane) {
    f32x4 v[8]; const float rstd = rms_row_load(xrow, lane, v);
    const f32x4* gr = (const f32x4*)gain + lane; unsigned long long* o8 = (unsigned long long*)orow + lane;
#pragma unroll
    for (int j = 0; j < 8; ++j) { const f32x4 g = gr[64 * j]; o8[64 * j] = (unsigned long long)pk2(v[j].x * rstd * g.x, v[j].y * rstd * g.y) | ((unsigned long long)pk2(v[j].z * rstd * g.z, v[j].w * rstd * g.w) << 32); }
}

namespace nsa {
constexpr int KST = 72;
constexpr int VST2 = 136;
constexpr int L_KS = 0;
constexpr int L_VT = 9216;
constexpr int L_KC = 18432;
constexpr int L_VC = 36864;
constexpr int L_IA = 54272;
constexpr int L_IB = 87040;
constexpr int L_MASK = 119808;
constexpr int L_TL = 120064;
constexpr int L_KS2 = 120576;
constexpr int L_VT2 = 129792;
__device__ __forceinline__ int kperm(int key) { return (key & ~12) | ((key & 4) << 1) | ((key & 8) >> 1); }

__device__ __forceinline__ void unit(LAS unsigned char* lds, const bf16* Z, const bf16* kct, const bf16* vct, bf16* OAp, int b, int g, int iq, const int tid_in) {
    int tid = tid_in; asm volatile("" : "+v"(tid));
    const int lane = tid & 63, r32 = lane & 31, hi = lane >> 5; const int w = __builtin_amdgcn_readfirstlane(tid >> 6);
    const int j = w >> 1, hq = 4 * g + j, tl = 32 * (w & 1) + r32, t0 = 64 * iq, t = t0 + tl;
    const size_t rowZ = (size_t)(b * T + t) * ZLD;
    LAS bf16* KS = (LAS bf16*)(lds + L_KS); LAS bf16* VT = (LAS bf16*)(lds + L_VT); LAS bf16* KC = (LAS bf16*)(lds + L_KC); LAS bf16* VC = (LAS bf16*)(lds + L_VC);
    LAS float* IA = (LAS float*)(lds + L_IA); LAS float* IB = (LAS float*)(lds + L_IB); LAS unsigned* MSK = (LAS unsigned*)(lds + L_MASK); LAS int* TL = (LAS int*)(lds + L_TL);
    bf16x8 qr[4];
#pragma unroll
    for (int d0 = 0; d0 < 4; ++d0) qr[d0] = *(const bf16x8*)(Z + rowZ + ZQ + hq * 64 + 16 * d0 + 8 * hi);
    const float slope2 = __builtin_amdgcn_exp2f(-0.5f * (float)(hq + 1)) * LOG2E;
    float gate[3];
#pragma unroll
    for (int x = 0; x < 3; ++x) gate[x] = sigmoidf_(bf2f(Z[rowZ + ZNG + hq * 3 + x]));
    f32x16 otot[2];
#pragma unroll
    for (int r = 0; r < 16; ++r) { otot[0][r] = 0.f; otot[1][r] = 0.f; }

    {
        const bf16* kc = kct + (size_t)((b * 4 + g) * 128) * 64; const bf16* vc = vct + (size_t)((b * 4 + g) * 128) * 64;
#pragma unroll
        for (int q = 0; q < 2; ++q) { const int idx = tid + 512 * q, key = idx >> 3, ch = idx & 7;
            const v4u kv = *(const v4u*)(kc + key * 64 + ch * 8); *(LAS v4u*)(KC + key * KST + ch * 8) = kv;
            const v4u vv = *(const v4u*)(vc + key * 64 + ch * 8); const int pos = kperm(key);
            const unsigned ww[4] = {vv.x, vv.y, vv.z, vv.w};
#pragma unroll
            for (int e = 0; e < 4; ++e) { VC[(ch * 8 + 2 * e) * VST2 + pos] = (bf16)(ww[e] & 0xffffu); VC[(ch * 8 + 2 * e + 1) * VST2 + pos] = (bf16)(ww[e] >> 16); } }
    }
    __syncthreads();
    {
        f32x16 p[4];
#pragma unroll
        for (int blk = 0; blk < 4; ++blk) {
#pragma unroll
            for (int r = 0; r < 16; ++r) p[blk][r] = 0.f;
#pragma unroll
            for (int d0 = 0; d0 < 4; ++d0) { const bf16x8 kf = *(const LAS bf16x8*)(KC + (32 * blk + r32) * KST + 16 * d0 + 8 * hi); p[blk] = MFMA32(kf, qr[d0], p[blk]); }
        }
        float mx = -INFINITY;
#pragma unroll
        for (int blk = 0; blk < 4; ++blk)
#pragma unroll
            for (int r = 0; r < 16; ++r) { const int c = 32 * blk + crow(r, hi); const int dist = t - (16 * c + 31); const bool ok = (dist >= 0) && (c < 127);
                const float s = ok ? p[blk][r] - slope2 * (float)dist : -INFINITY; p[blk][r] = s; mx = fmaxf(mx, s); }
        mx = fmaxf(mx, __shfl_xor(mx, 32));
        const float msafe = (mx == -INFINITY) ? 0.f : mx;
        float l = 0.f;
#pragma unroll
        for (int blk = 0; blk < 4; ++blk)
#pragma unroll
            for (int r = 0; r < 16; ++r) { const float e = __builtin_amdgcn_exp2f(p[blk][r] - msafe); p[blk][r] = e; l += e; }
        l += __shfl_xor(l, 32);
        const float inv = l > 0.f ? 1.0f / l : 0.f;
#pragma unroll
        for (int blk = 0; blk < 4; ++blk)
#pragma unroll
            for (int r = 0; r < 16; ++r) p[blk][r] *= inv;
#pragma unroll
        for (int blk = 0; blk < 4; ++blk)
#pragma unroll
            for (int rq = 0; rq < 4; ++rq) { const int n = 8 * blk + 2 * rq + hi;
                IA[(j * 64 + tl) * 32 + n] = 2.f * (p[blk][4 * rq] + p[blk][4 * rq + 1] + p[blk][4 * rq + 2]) + p[blk][4 * rq + 3];
                IB[(j * 64 + tl) * 32 + n] = p[blk][4 * rq + 3]; }
        f32x16 oc[2];
#pragma unroll
        for (int r = 0; r < 16; ++r) { oc[0][r] = 0.f; oc[1][r] = 0.f; }
#pragma unroll
        for (int s = 0; s < 8; ++s) { const int blk = s >> 1, rb = 8 * (s & 1);
            u32x4 pw; pw.x = cvt_pk_bf16(p[blk][rb + 0], p[blk][rb + 1]); pw.y = cvt_pk_bf16(p[blk][rb + 2], p[blk][rb + 3]); pw.z = cvt_pk_bf16(p[blk][rb + 4], p[blk][rb + 5]); pw.w = cvt_pk_bf16(p[blk][rb + 6], p[blk][rb + 7]);
            const bf16x8 pa = __builtin_bit_cast(bf16x8, pw);
#pragma unroll
            for (int db = 0; db < 2; ++db) { const bf16x8 vf = *(const LAS bf16x8*)(VC + (32 * db + r32) * VST2 + 16 * s + 8 * hi); oc[db] = MFMA32(vf, pa, oc[db]); } }
#pragma unroll
        for (int r = 0; r < 16; ++r) { otot[0][r] += gate[0] * oc[0][r]; otot[1][r] += gate[0] * oc[1][r]; }
    }
    __syncthreads();
    {
        const int n = lane & 31;
#pragma unroll
        for (int q = 0; q < 4; ++q) { const int tk = (tid >> 5) + 16 * q;
            float imp = 0.f;
#pragma unroll
            for (int jj = 0; jj < 4; ++jj) { imp += IA[(jj * 64 + tk) * 32 + n]; if (n > 0) imp += IB[(jj * 64 + tk) * 32 + n - 1]; }
            const bool valid = n <= iq, forced = (n == 0) || (n == iq) || (n == iq - 1);
            const float sc = forced ? 1e4f : (valid ? imp : -1.0f);
            int cnt = 0;
#pragma unroll
            for (int mm = 0; mm < 32; ++mm) { const float so = __shfl(sc, (lane & 32) + mm); cnt += (so > sc || (so == sc && mm < n)) ? 1 : 0; }
            const unsigned long long bal = __ballot(cnt < 16);
            if (n == 0) MSK[tk] = (unsigned)((lane & 32) ? (bal >> 32) : bal); }
    }
    __syncthreads();
    const unsigned mymask = MSK[tl];
    if (tid < 64) {
        unsigned un = MSK[lane];
#pragma unroll
        for (int o = 1; o < 64; o <<= 1) un |= __shfl_xor(un, o);
        if (lane == 0) { int cnt = 0;
            for (int n = iq; n >= 0; --n) if ((un >> n) & 1u) TL[1 + cnt++] = n | 0x100;
            for (int n = iq; n >= (iq >= 8 ? iq - 8 : 0); --n) TL[1 + cnt++] = n | 0x200;
            TL[0] = cnt; }
    }
    __syncthreads();
    {
        const int ntile = TL[0];
        const int skey = tid >> 3, sch = tid & 7;
        const int vkp = tid & 31, vc4 = tid >> 5, vpos = kperm(2 * vkp);
        LAS bf16* KSb[2] = {KS, KC}; LAS bf16* VTb[2] = {VT, VC};
        v4u kreg, vreg;
#define NSA_LOAD(ee) do { const int n_ = (ee) & 0xff, br_ = (ee) >> 8; const size_t ro_ = (size_t)(b * T + 64 * n_ + skey) * ZLD + g * 64 + sch * 8; \
            kreg = *(const v4u*)(Z + ro_ + (br_ == 1 ? ZKS : ZKW)); \
            const size_t rv_ = (size_t)(b * T + 64 * n_ + 2 * vkp) * ZLD + g * 64 + 4 * vc4 + (br_ == 1 ? ZVS : ZVW); \
            const v2u va_ = *(const v2u*)(Z + rv_), vb_ = *(const v2u*)(Z + rv_ + ZLD); vreg = (v4u){va_.x, va_.y, vb_.x, vb_.y}; } while (0)
#define NSA_STORE(bi) do { *(LAS v4u*)(KSb[bi] + skey * KST + sch * 8) = kreg; \
              \
            LAS unsigned* vt_ = (LAS unsigned*)(VTb[bi] + (4 * vc4) * KST + vpos); \
            vt_[0 * (KST / 2)] = (vreg.x & 0xffffu) | (vreg.z << 16); vt_[1 * (KST / 2)] = (vreg.x >> 16) | (vreg.z & 0xffff0000u); \
            vt_[2 * (KST / 2)] = (vreg.y & 0xffffu) | (vreg.w << 16); vt_[3 * (KST / 2)] = (vreg.y >> 16) | (vreg.w & 0xffff0000u); } while (0)
        NSA_LOAD(TL[1]); NSA_STORE(0);
        if (ntile > 1) NSA_LOAD(TL[2]);
        asm volatile("s_waitcnt lgkmcnt(0)\n\ts_barrier" ::: "memory");
        float mref = 0.f, l_run = 0.f; f32x16 o[2];
#pragma unroll
        for (int r = 0; r < 16; ++r) { o[0][r] = 0.f; o[1][r] = 0.f; }
        int curbr = TL[1] >> 8; bool first = true;
        for (int k = 0; k < ntile; ++k) {
            const int e = TL[1 + k], n = e & 0xff, br = e >> 8, bi = k & 1;
            if (br != curbr) {
                l_run += __shfl_xor(l_run, 32);
                const float sc = gate[1] / l_run;
#pragma unroll
                for (int r = 0; r < 16; ++r) { otot[0][r] += sc * o[0][r]; otot[1][r] += sc * o[1][r]; o[0][r] = 0.f; o[1][r] = 0.f; }
                mref = 0.f; l_run = 0.f; curbr = br; first = true;
            }
            const bool sel = (br == 1) ? (((mymask >> n) & 1u) != 0u) : true;
            const float base = sel ? (slope2 * (float)(64 * n + 4 * hi - t) - mref) : -INFINITY;
            f32x16 p0, p1;
            if (n == iq) {
#pragma unroll
                for (int r = 0; r < 16; ++r) { const float cr = (float)((r & 3) + 8 * (r >> 2)); const int c = crow(r, hi);
                    p0[r] = (c > tl) ? -INFINITY : fmaf(slope2, cr, base); p1[r] = (c + 32 > tl) ? -INFINITY : fmaf(slope2, cr + 32.f, base); }
            } else if (br == 2 && n == iq - 8) {
#pragma unroll
                for (int r = 0; r < 16; ++r) { const float cr = (float)((r & 3) + 8 * (r >> 2)); const int c = crow(r, hi);
                    p0[r] = (c <= tl) ? -INFINITY : fmaf(slope2, cr, base); p1[r] = (c + 32 <= tl) ? -INFINITY : fmaf(slope2, cr + 32.f, base); }
            } else {
#pragma unroll
                for (int r = 0; r < 16; ++r) { const float cr = (float)((r & 3) + 8 * (r >> 2)); p0[r] = fmaf(slope2, cr, base); p1[r] = fmaf(slope2, cr + 32.f, base); }
            }
#pragma unroll
            for (int d0 = 0; d0 < 4; ++d0) {
                const bf16x8 k0 = *(const LAS bf16x8*)(KSb[bi] + r32 * KST + 16 * d0 + 8 * hi);
                const bf16x8 k1 = *(const LAS bf16x8*)(KSb[bi] + (r32 + 32) * KST + 16 * d0 + 8 * hi);
                p0 = MFMA32(k0, qr[d0], p0); p1 = MFMA32(k1, qr[d0], p1); }
            float mx = fmaxf(p0[0], p1[0]);
#pragma unroll
            for (int r = 1; r < 16; ++r) mx = fmaxf(mx, fmaxf(p0[r], p1[r]));
            mx = fmaxf(mx, __shfl_xor(mx, 32));
            if (first) {
                const float dl = (mx == -INFINITY) ? 0.f : mx; mref += dl;
#pragma unroll
                for (int r = 0; r < 16; ++r) { p0[r] -= dl; p1[r] -= dl; }
                first = false;
            } else if (__any(mx > 8.0f)) {
                const float dl = fmaxf(mx, 0.f); mref += dl;
                const float f = __builtin_amdgcn_exp2f(-dl); l_run *= f;
#pragma unroll
                for (int r = 0; r < 16; ++r) { p0[r] -= dl; p1[r] -= dl; o[0][r] *= f; o[1][r] *= f; }
            }
            float rs = 0.f;
#pragma unroll
            for (int r = 0; r < 16; ++r) { p0[r] = __builtin_amdgcn_exp2f(p0[r]); p1[r] = __builtin_amdgcn_exp2f(p1[r]); rs += p0[r] + p1[r]; }
            l_run += rs;
#pragma unroll
            for (int s = 0; s < 4; ++s) {
                u32x4 pw;
                if (s < 2) { const int rb = 8 * s; pw.x = cvt_pk_bf16(p0[rb + 0], p0[rb + 1]); pw.y = cvt_pk_bf16(p0[rb + 2], p0[rb + 3]); pw.z = cvt_pk_bf16(p0[rb + 4], p0[rb + 5]); pw.w = cvt_pk_bf16(p0[rb + 6], p0[rb + 7]); }
                else { const int rb = 8 * (s - 2); pw.x = cvt_pk_bf16(p1[rb + 0], p1[rb + 1]); pw.y = cvt_pk_bf16(p1[rb + 2], p1[rb + 3]); pw.z = cvt_pk_bf16(p1[rb + 4], p1[rb + 5]); pw.w = cvt_pk_bf16(p1[rb + 6], p1[rb + 7]); }
                const bf16x8 pa = __builtin_bit_cast(bf16x8, pw);
#pragma unroll
                for (int db = 0; db < 2; ++db) { const bf16x8 vf = *(const LAS bf16x8*)(VTb[bi] + (32 * db + r32) * KST + 16 * s + 8 * hi); o[db] = MFMA32(vf, pa, o[db]); } }
            if (k + 1 < ntile) { NSA_STORE(bi ^ 1); if (k + 2 < ntile) NSA_LOAD(TL[3 + k]); }
            asm volatile("s_waitcnt lgkmcnt(0)\n\ts_barrier" ::: "memory");
        }
        { l_run += __shfl_xor(l_run, 32); const float sc = gate[2] / l_run;
#pragma unroll
          for (int r = 0; r < 16; ++r) { otot[0][r] += sc * o[0][r]; otot[1][r] += sc * o[1][r]; } }
#undef NSA_LOAD
#undef NSA_STORE
    }
    {
        bf16* orow = OAp + (size_t)(b * T + t) * 1024 + hq * 64;
#pragma unroll
        for (int db = 0; db < 2; ++db)
#pragma unroll
            for (int rq = 0; rq < 4; ++rq) { v2u wv; wv.x = cvt_pk_bf16(otot[db][4 * rq], otot[db][4 * rq + 1]); wv.y = cvt_pk_bf16(otot[db][4 * rq + 2], otot[db][4 * rq + 3]);
                *(v2u*)(orow + 32 * db + 8 * rq + 4 * hi) = wv; }
    }
    __syncthreads();
}
}

namespace sgu {
constexpr int ST = 136;
constexpr int L_W = 0;
constexpr int L_V = 34816;
constexpr int L_U = 69632;
constexpr int L_STAT = 104448;
constexpr int L_B = 105472;
__device__ __forceinline__ void unit(LAS unsigned char* lds, const bf16* Z, const bf16* sgw, const float* lng, const float* lnb, const float* sgb, bf16* OBp, int b, int nchunk, int g0, int ng, const int tid_in) {
    int tid = tid_in; asm volatile("" : "+v"(tid));
    const int lane = tid & 63, r32 = lane & 31, hi = lane >> 5; const int w = __builtin_amdgcn_readfirstlane(tid >> 6);
    LAS bf16* WL = (LAS bf16*)(lds + L_W); LAS bf16* VL = (LAS bf16*)(lds + L_V); LAS bf16* UL = (LAS bf16*)(lds + L_U); LAS float* STAT = (LAS float*)(lds + L_STAT); LAS float* BL = (LAS float*)(lds + L_B);
    const int tb0 = b * T + 128 * nchunk;
    for (int k = 0; k < 16; ++k) { const int tok = 16 * w + k; const bf16* row = Z + (size_t)(tb0 + tok) * ZLD + ZV;
        float s = 0.f, ss = 0.f;
#pragma unroll
        for (int q = 0; q < 2; ++q) { const v4u vv = *(const v4u*)(row + q * 512 + lane * 8); const unsigned ww[4] = {vv.x, vv.y, vv.z, vv.w};
#pragma unroll
            for (int e = 0; e < 4; ++e) { const float a = bflo(ww[e]), c = bfhi(ww[e]); s += a + c; ss += a * a + c * c; } }
        s = wave_sum(s); ss = wave_sum(ss);
        const float mean = s * (1.0f / 1024.0f); const float var = fmaxf(ss * (1.0f / 1024.0f) - mean * mean, 0.f);
        if (lane == 0) { STAT[tok * 2] = mean; STAT[tok * 2 + 1] = 1.0f / sqrtf(var + EPS); } }
    __syncthreads();
#pragma unroll 1
    for (int g = g0; g < g0 + ng; ++g) {
        if (tid < 128) BL[tid] = sgb[g * 128 + tid];
#pragma unroll
        for (int q = 0; q < 4; ++q) { const int idx = tid + 512 * q, row = idx >> 4, ch = idx & 15;
            *(LAS v4u*)(WL + row * ST + ch * 8) = *(const v4u*)(sgw + (size_t)(g * 128 + row) * 128 + ch * 8);
            *(LAS v4u*)(UL + row * ST + ch * 8) = *(const v4u*)(Z + (size_t)(tb0 + row) * ZLD + ZU + g * 128 + ch * 8);
            const v4u vv = *(const v4u*)(Z + (size_t)(tb0 + row) * ZLD + ZV + g * 128 + ch * 8); const unsigned ww[4] = {vv.x, vv.y, vv.z, vv.w};
            const float mean = STAT[row * 2], rstd = STAT[row * 2 + 1];
#pragma unroll
            for (int e = 0; e < 4; ++e) { const int c0 = g * 128 + ch * 8 + 2 * e;
                const float a = (bflo(ww[e]) - mean) * rstd * lng[c0] + lnb[c0], c = (bfhi(ww[e]) - mean) * rstd * lng[c0 + 1] + lnb[c0 + 1];
                VL[(ch * 8 + 2 * e) * ST + row] = (bf16)f2bf(a); VL[(ch * 8 + 2 * e + 1) * ST + row] = (bf16)f2bf(c); } }
        __syncthreads();
        const int tb = w >> 1, dbase = (w & 1) * 2;
        f32x16 acc[2];
#pragma unroll
        for (int r = 0; r < 16; ++r) { acc[0][r] = 0.f; acc[1][r] = 0.f; }
        for (int ks = 0; ks < 2 * (tb + 1); ++ks) {
            const bf16x8 a = *(const LAS bf16x8*)(WL + (32 * tb + r32) * ST + 16 * ks + 8 * hi);
#pragma unroll
            for (int x = 0; x < 2; ++x) { const bf16x8 bb = *(const LAS bf16x8*)(VL + (32 * (dbase + x) + r32) * ST + 16 * ks + 8 * hi); acc[x] = MFMA32(a, bb, acc[x]); } }
#pragma unroll
        for (int x = 0; x < 2; ++x)
#pragma unroll
            for (int r = 0; r < 16; ++r) { const int tt = 32 * tb + crow(r, hi); LAS bf16* up = UL + tt * ST + 32 * (dbase + x) + r32;
                *up = (bf16)f2bf(bf2f(*up) * (acc[x][r] + BL[tt])); }
        __syncthreads();
#pragma unroll
        for (int q = 0; q < 4; ++q) { const int idx = tid + 512 * q, row = idx >> 4, ch = idx & 15;
            *(v4u*)(OBp + (size_t)(tb0 + row) * 1024 + g * 128 + ch * 8) = *(const LAS v4u*)(UL + row * ST + ch * 8); }
        __syncthreads();
    }
}
}

#define WIN_T ((bf16*)(ws + WS_WIN))
#define CW1_T ((bf16*)(ws + WS_CW1))
#define CW2_T ((bf16*)(ws + WS_CW2))
#define CB1 ((float*)(ws + WS_CB1))
#define WA_T ((bf16*)(ws + WS_WA))
#define WB_T ((bf16*)(ws + WS_WB))
#define WO_T ((bf16*)(ws + WS_WO))
#define SGW ((bf16*)(ws + WS_SGW))
#define FUP_T ((bf16*)(ws + WS_FUP))
#define FDN_T ((bf16*)(ws + WS_FDN))
#define MUP_T ((bf16*)(ws + WS_MUP))
#define MDN_T ((bf16*)(ws + WS_MDN))
#define Hb ((bf16*)(ws + WS_H))
#define XA ((float*)(ws + WS_XA))
#define HPERM ((bf16*)(ws + WS_HPERM))
#define YPERM ((bf16*)(ws + WS_YPERM))
#define KCT ((bf16*)(ws + WS_KCT))
#define HID ((bf16*)(ws + WS_HID))
#define Zb ((bf16*)(ws + WS_Z))
#define FLAT ((bf16*)(ws + WS_FLAT))
#define OA ((bf16*)(ws + WS_OA))
#define OB ((bf16*)(ws + WS_OB))
#define TMP ((bf16_t*)(ws + WS_TMP))
#define Yb ((bf16*)(ws + WS_Y))
#define GBUF ((bf16*)(ws + WS_GBUF))
#define TOKE ((int*)(ws + WS_ROUTE + RT_TOKE))
#define TOKW ((float*)(ws + WS_ROUTE + RT_TOKW))
#define TOKP ((int*)(ws + WS_ROUTE + RT_TOKP))
#define RGATE ((float*)(ws + WS_ROUTE + RT_RGATE))
#define CNT ((int*)(ws + WS_ROUTE + RT_CNT))
#define TILEE ((int*)(ws + WS_ROUTE + RT_TILEE))
__global__ void __launch_bounds__(NWAVES * 64, 2) trunk_fwd(Args args) {
    extern __shared__ __attribute__((aligned(16))) unsigned char lds_raw[];
    LAS unsigned char* lds = (LAS unsigned char*)lds_raw;
    volatile LAS unsigned* MISC = (volatile LAS unsigned*)(lds + LDS_MISC);
    const int tid = threadIdx.x, lane = tid & 63; const int wave = __builtin_amdgcn_readfirstlane(tid >> 6);
    const int G = gridDim.x, bx = blockIdx.x;
    unsigned char* ws = args.ws;
    unsigned* ctl = (unsigned*)(ws + WS_CTL);
    for (int u = tid; u < (LDS_BYTES - LDS_MISC) / 4; u += NWAVES * 64) ((LAS unsigned*)(lds + LDS_MISC))[u] = 0u;
    __syncthreads();
    const int lo = args.ph_lo, hi = args.ph_hi;
    XcdBarrier bar; bar.bar = ctl + CW_BAR; bar.x = 0; bar.st = nullptr;
    if (hi - lo > 1) bar = xcd_barrier_post(ctl + CW_BAR, MISC + 8);
#ifndef PH_MASK
#define PH_MASK 0xFFFFFFFFu
#endif
#define EN(i) (((PH_MASK) >> (i)) & 1u)
#define IN(k) (lo <= (k) && (k) < hi)
#define SEAM(k) do { if (IN(k) && IN((k) + 1)) xcd_barrier(bar); } while (0)

    const int gw = bx * NWAVES + wave, ngw = G * NWAVES;

    if (EN(0) && IN(0)) {
        LAS float* scr = (LAS float*)(lds + wave * 16384);
        if (wave < 4 && bx >= G - 32 && G >= 32) { const int tk = (bx - (G - 32)) * 4 + wave, l = tk >> 6, kv = (tk >> 5) & 1, n = (tk & 31) * 8 + (lane & 7), k8 = lane >> 3;
            const float* pe = args.in[kv ? I_PEV : I_PEK] + (size_t)l * 2048; const float* w1 = args.in[kv ? I_VW1 : I_KW1] + (size_t)l * 2048 * 256;
            float sacc = 0.f;
#pragma unroll 16
            for (int k = k8; k < 2048; k += 8) sacc += pe[k] * w1[(size_t)k * 256 + n];
            sacc += __shfl_xor(sacc, 8); sacc += __shfl_xor(sacc, 16); sacc += __shfl_xor(sacc, 32);
            if (k8 == 0) CB1[(l * 2 + kv) * 256 + n] = sacc; }
        {
            constexpr int C_WIN = 2 * 32 * 35, C_WAB = 2 * 2 * 16 * 8, C_WO = 2 * 32 * 8, C_CW1 = 4 * 32, C_CW2 = 4 * 4, C_F13 = 2 * 32 * 22, C_F2 = 88 * 8, C_M13 = 8 * 2 * 32 * 28, C_M2 = 8 * 112 * 8;
            constexpr int C_TOT = C_WIN + C_WAB + C_WO + C_CW1 + C_CW2 + C_F13 + C_F2;
            for (int it = bx; it < C_TOT; it += G) {
                int r = it;
                if (r < C_WIN) { const int l = r / (32 * 35), q = r % (32 * 35); conv_tile(args.in[I_WIN] + (size_t)l * D * IN_W, IN_W, D, IN_W, WIN_T + (size_t)l * ZLD * D, 1, q / 35, q % 35, lane, wave, wave + 1); continue; } r -= C_WIN;
                if (r < C_WAB) { const int ab = r / (2 * 16 * 8), l = (r / (16 * 8)) & 1, q = r % (16 * 8); conv_tile(args.in[ab ? I_WB : I_WA] + (size_t)l * 1024 * 2048, 2048, 1024, 2048, (ab ? WB_T : WA_T) + (size_t)l * 2048 * 1024, 0, q / 8, q % 8, lane, wave, wave + 1); continue; } r -= C_WAB;
                if (r < C_WO) { const int l = r / (32 * 8), q = r % (32 * 8); conv_tile(args.in[I_WO] + (size_t)l * 2048 * 2048, 2048, 2048, 2048, WO_T + (size_t)l * 2048 * 2048, 0, q / 8, q % 8, lane, wave, wave + 1); continue; } r -= C_WO;
                if (r < C_CW1) { const int lk = r / 32, q = r % 32; conv_tile(args.in[(lk & 1) ? I_VW1 : I_KW1] + (size_t)(lk >> 1) * 2048 * 256, 256, 2048, 256, CW1_T + (size_t)lk * 256 * 2048, 0, q, 0, lane, wave, wave + 1); continue; } r -= C_CW1;
                if (r < C_CW2) { const int lk = r / 4, q = r % 4; conv_tile(args.in[(lk & 1) ? I_VW2 : I_KW2] + (size_t)(lk >> 1) * 256 * 64, 64, 256, 64, CW2_T + (size_t)lk * 64 * 256, 0, q, 0, lane, wave, wave + 1); continue; } r -= C_CW2;
                if (r < C_F13) { const int w3 = r / (32 * 22), q = r % (32 * 22); conv_tile(args.in[w3 ? I_F3 : I_F1], FFD, D, FFD, FUP_T, 2 + w3, q / 22, q % 22, lane, wave, wave + 1); continue; } r -= C_F13;
                { conv_tile(args.in[I_F2], 2048, FFD, 2048, FDN_T, 0, r / 8, r % 8, lane, wave, wave + 1); }
            }
            for (int i = bx * 512 + tid; i < 2 * 208 * 256; i += G * 512) { const int l = i / (208 * 256), q = i % (208 * 256); *(u32x4*)(WIN_T + (size_t)l * ZLD * D + (size_t)(2608 + q / 256) * D + (q % 256) * 8) = (u32x4){0u, 0u, 0u, 0u}; }
        }
        for (int idx = bx * 512 + tid; idx < 2 * 8 * 128 * 128; idx += G * 512) { const int tt = (idx >> 7) & 127, s = idx & 127; SGW[idx] = (bf16)f2bf(s <= tt ? args.in[I_SGW][idx] : 0.f); }
        for (int m = gw; m < M; m += ngw) rms_row_to_bf16(args.in[I_X] + (size_t)m * D, args.in[I_NMIX], Hb + (size_t)m * D, lane);
    }
    SEAM(0);

    for (int layer = 0; layer < 2; ++layer) {
        const int pb = 1 + layer * 11;
        const float* xin = layer == 0 ? args.in[I_X] : XA;
        if (EN(1) && IN(pb + 0)) {
            int tz = threadIdx.x; asm volatile("" : "+v"(tz)); const int lane = tz & 63; const int wave = __builtin_amdgcn_readfirstlane(tz >> 6); const int tid = tz; const int gw = bx * NWAVES + wave; (void)lane; (void)tid; (void)gw;
            const int gg = (G == 256) ? 224 : G;
            if (bx < gg) {
                pg8::Gemm g{Hb, WIN_T + (size_t)layer * ZLD * D, M, ZLD, D, 0}; pg8::StaticOrder S; S.init(M, ZLD, gg, bx);
                pg8::EpiWin E{Zb, FLAT};
                pg8::gemm_phase(lds, g, S, E, tz, ctl + CW_DONE(layer * 3 + 0));
            } else conv_run(args.in[I_M1], args.in[I_M3], args.in[I_M2], MUP_T, MDN_T, ctl, MISC + 16, true, ctl + CW_DONE(layer * 3 + 0), 16u, 1 << 30, 1);
        }
        SEAM(pb + 0);
        if (EN(2) && IN(pb + 1)) {
            int tz = threadIdx.x; asm volatile("" : "+v"(tz)); const int lane = tz & 63; const int wave = __builtin_amdgcn_readfirstlane(tz >> 6); const int tid = tz; const int gw = bx * NWAVES + wave; (void)lane; (void)tid; (void)gw;
            if (bx < 16) {
                pg8::Gemm g{FLAT, CW1_T + (size_t)layer * 2 * 256 * 2048, 4096, 256, 2048, (size_t)256 * 2048 * 2}; pg8::CmpOrder S{bx};
                pg8::EpiCmp E{HID, CB1 + layer * 512};
                pg8::gemm_phase(lds, g, S, E, tz);
                __builtin_amdgcn_fence(__ATOMIC_RELEASE, "workgroup"); __syncthreads(); __builtin_amdgcn_fence(__ATOMIC_ACQUIRE, "workgroup");
                const int wt = bx * NWAVES + wave;
                if (wt < 128) { const int kv = wt >> 6, rb = wt & 63, r32 = lane & 31, hh = lane >> 5;
                    const bf16* A = HID + (size_t)(kv * 2048 + 32 * rb + r32) * 256; const bf16* W2 = CW2_T + (size_t)(layer * 2 + kv) * 64 * 256;
                    f32x16 acc[2];
    #pragma unroll
                    for (int r = 0; r < 16; ++r) { acc[0][r] = 0.f; acc[1][r] = 0.f; }
    #pragma unroll 8
                    for (int ks = 0; ks < 16; ++ks) { const bf16x8 a = *(const bf16x8*)(A + 16 * ks + 8 * hh);
    #pragma unroll
                        for (int nb = 0; nb < 2; ++nb) { const bf16x8 bb = *(const bf16x8*)(W2 + (size_t)(32 * nb + r32) * 256 + 16 * ks + 8 * hh); acc[nb] = MFMA32(a, bb, acc[nb]); } }
    #pragma unroll
                    for (int nb = 0; nb < 2; ++nb)
    #pragma unroll
                        for (int r = 0; r < 16; ++r) { const int rho = 32 * rb + crow(r, hh), b = rho >> 9, c = (rho >> 2) & 127, gg = rho & 3;
                            KCT[(size_t)kv * 16 * 128 * 64 + (size_t)((b * 4 + gg) * 128 + c) * 64 + 32 * nb + r32] = (bf16)f2bf(acc[nb][r]); } }
            } else if (bx < 144 || G < 160) {
                for (int u = bx - 16; u < 128; u += (G < 160 ? G : 144) - 16)
                    sgu::unit(lds, Zb, SGW + (size_t)layer * 8 * 128 * 128, args.in[I_LNG] + layer * 1024, args.in[I_LNB] + layer * 1024, args.in[I_SGB] + layer * 1024, OB, u >> 5, (u >> 1) & 15, (u & 1) * 4, 4, tz);
                __syncthreads();
                conv_run(args.in[I_M1], args.in[I_M3], args.in[I_M2], MUP_T, MDN_T, ctl, MISC + 16, true, nullptr, 0u, 1);
            } else conv_run(args.in[I_M1], args.in[I_M3], args.in[I_M2], MUP_T, MDN_T, ctl, MISC + 16, true, nullptr, 0u, 4);
        }
        SEAM(pb + 1);
        if (EN(4) && IN(pb + 3)) {
            int tz = threadIdx.x; asm volatile("" : "+v"(tz)); const int lane = tz & 63; const int wave = __builtin_amdgcn_readfirstlane(tz >> 6); const int tid = tz; const int gw = bx * NWAVES + wave; (void)lane; (void)tid; (void)gw;
            for (int L = bx; L < 512; L += G) { int bg, iq;
                if (G == 256) {
                    const int r = bx >> 3; bg = 2 * (bx & 7) + (r >> 4); iq = (L < 256) ? 31 - (r & 15) : (r & 15); }
                else if (L < 256) { bg = L >> 4; iq = 31 - (L & 15); } else { bg = (L - 256) >> 4; iq = (L - 256) & 15; }
                nsa::unit(lds, Zb, KCT, KCT + (size_t)16 * 128 * 64, OA, bg >> 2, bg & 3, iq, tz); }
            __syncthreads();
            signal_done(ctl + CW_DONE(6 + layer), wave);
            if (G == 256) conv_run(args.in[I_M1], args.in[I_M3], args.in[I_M2], MUP_T, MDN_T, ctl, MISC + 16, true, ctl + CW_DONE(6 + layer), 128u, 1 << 30);
        }
        SEAM(pb + 3);
        if (EN(5) && IN(pb + 4)) {
            int tz = threadIdx.x; asm volatile("" : "+v"(tz)); const int lane = tz & 63; const int wave = __builtin_amdgcn_readfirstlane(tz >> 6); const int tid = tz; const int gw = bx * NWAVES + wave; (void)lane; (void)tid; (void)gw;
            pg8::EpiGate E{Zb, TMP, Yb};
            { pg8::Gemm g{OA, WA_T + (size_t)layer * 2048 * 1024, M, D, 1024, 0}; pg8::StaticOrder S; S.init(M, D, G, bx, 0); pg8::gemm_phase(lds, g, S, E, tz); }
            { pg8::Gemm g{OB, WB_T + (size_t)layer * 2048 * 1024, M, D, 1024, 0}; pg8::StaticOrder S; S.init(M, D, G, bx, 1); pg8::gemm_phase(lds, g, S, E, tz); }
        }
        SEAM(pb + 4);
        if (EN(6) && IN(pb + 5)) {
            int tz = threadIdx.x; asm volatile("" : "+v"(tz)); const int lane = tz & 63; const int wave = __builtin_amdgcn_readfirstlane(tz >> 6); const int tid = tz; const int gw = bx * NWAVES + wave; (void)lane; (void)tid; (void)gw;
            pg8::Gemm g{Yb, WO_T + (size_t)layer * 2048 * 2048, M, D, D, 0}; pg8::StaticOrder S; S.init(M, D, G, bx);
            pg8::EpiResid E{xin, XA};
            pg8::gemm_phase(lds, g, S, E, tz);
        }
        SEAM(pb + 5);
        if (EN(7) && IN(pb + 6)) {
            int tz = threadIdx.x; asm volatile("" : "+v"(tz)); const int lane = tz & 63; const int wave = __builtin_amdgcn_readfirstlane(tz >> 6); const int tid = tz; const int gw = bx * NWAVES + wave; (void)lane; (void)tid; (void)gw;
            const float* gain = args.in[I_NFFN] + layer * D;
            if (layer == 0) { for (int m = gw; m < M; m += ngw) rms_row_to_bf16(XA + (size_t)m * D, gain, Hb + (size_t)m * D, lane); }
            else {
                LAS float* RW = (LAS float*)lds;
                LAS int* LC = (LAS int*)(lds + 65536);
                for (int i = tid; i < 2048 * 8; i += 512) RW[i] = args.in[I_RW][i];
                if (tid < 8) LC[tid] = 0;
                __syncthreads();
                const int rpb = (M + G - 1) / G, r0 = bx * rpb, r1 = (r0 + rpb) < M ? (r0 + rpb) : M;
                for (int m = r0 + wave; m < r1; m += NWAVES) {
                    f32x4 v[8]; const float rstd = rms_row_load(XA + (size_t)m * D, lane, v);
                    const f32x4* gr = (const f32x4*)gain + lane; unsigned long long* o8 = (unsigned long long*)(Hb + (size_t)m * D) + lane;
                    float lg[8];
#pragma unroll
                    for (int e = 0; e < 8; ++e) lg[e] = 0.f;
#pragma unroll
                    for (int jj = 0; jj < 8; ++jj) { const f32x4 gg = gr[64 * jj]; const float a0 = v[jj].x * rstd * gg.x, a1 = v[jj].y * rstd * gg.y, a2 = v[jj].z * rstd * gg.z, a3 = v[jj].w * rstd * gg.w;
                        o8[64 * jj] = (unsigned long long)pk2(a0, a1) | ((unsigned long long)pk2(a2, a3) << 32);
                        const int c0 = 256 * jj + 4 * lane; const float av[4] = {a0, a1, a2, a3};
#pragma unroll
                        for (int q = 0; q < 4; ++q) { const f32x4 w0 = *(const LAS f32x4*)(RW + (c0 + q) * 8), w1 = *(const LAS f32x4*)(RW + (c0 + q) * 8 + 4);
                            lg[0] += av[q] * w0.x; lg[1] += av[q] * w0.y; lg[2] += av[q] * w0.z; lg[3] += av[q] * w0.w; lg[4] += av[q] * w1.x; lg[5] += av[q] * w1.y; lg[6] += av[q] * w1.z; lg[7] += av[q] * w1.w; } }
#pragma unroll
                    for (int e = 0; e < 8; ++e) lg[e] = wave_sum(lg[e]) + args.in[I_RB][e];
                    if (lane == 0) { int e0 = 0; float v0 = lg[0];
#pragma unroll
                        for (int e = 1; e < 8; ++e) if (lg[e] > v0) { v0 = lg[e]; e0 = e; }
                        int e1 = -1; float v1 = -INFINITY;
#pragma unroll
                        for (int e = 0; e < 8; ++e) if (e != e0 && lg[e] > v1) { v1 = lg[e]; e1 = e; }
                        const float w0 = 1.0f / (1.0f + expf(v1 - v0));
                        TOKE[2 * m] = e0; TOKE[2 * m + 1] = e1; TOKW[2 * m] = w0; TOKW[2 * m + 1] = 1.0f - w0;
                        atomicAdd((int*)&LC[e0], 1); atomicAdd((int*)&LC[e1], 1); }
                }
                __syncthreads();
                if (tid < 8) CNT[bx * 32 + tid] = LC[tid];
            }
        }
        SEAM(pb + 6);
        if (EN(8) && IN(pb + 7) && layer == 1) {
            int tz = threadIdx.x; asm volatile("" : "+v"(tz)); const int lane = tz & 63; const int wave = __builtin_amdgcn_readfirstlane(tz >> 6); const int tid = tz; const int gw = bx * NWAVES + wave; (void)lane; (void)tid; (void)gw;
            LAS int* SH = (LAS int*)lds;
            const int rpb = (M + G - 1) / G, r0 = bx * rpb, r1 = (r0 + rpb) < M ? (r0 + rpb) : M, npair = 2 * (r1 - r0);
            if (tid < 64) SH[tid] = 0;
            __syncthreads();
            for (int base = 0; base < G; base += 512) {
                const int bb = base + tid;
#pragma unroll
                for (int e = 0; e < 8; ++e) { const int c = bb < G ? CNT[bb * 32 + e] : 0; const float tot = wave_sum((float)c), bef = wave_sum(bb < bx ? (float)c : 0.f);
                    if (lane == 0) { atomicAdd((int*)&SH[e], (int)tot); atomicAdd((int*)&SH[8 + e], (int)bef); } } }
            for (int q = tid; q < npair; q += 512) SH[64 + q] = TOKE[2 * r0 + q];
            __syncthreads();
            if (tid == 0) { int acc = 0;
#pragma unroll 1
                for (int e = 0; e < 8; ++e) { SH[16 + e] = acc; const int nt = (SH[e] + 255) >> 8; if (bx == 0) for (int q = 0; q < nt; ++q) TILEE[acc + q] = e; acc += nt; } SH[24] = acc; if (bx == 0) TILEE[127] = acc;
                if (npair > 64) for (int q = 0; q < npair; ++q) { const int e = SH[64 + q]; SH[320 + q] = SH[16 + e] * 256 + SH[8 + e] + SH[32 + e]; SH[32 + e] += 1; } }
            __syncthreads();
            if (npair <= 64 && tid < 64) {
                const int e = tid < npair ? SH[64 + tid] : -1; int rank = 0;
#pragma unroll
                for (int x = 0; x < 8; ++x) { const unsigned long long mk = __ballot(e == x); if (e == x) rank = __builtin_popcountll(mk & ((1ull << tid) - 1ull)); }
                if (tid < npair) SH[320 + tid] = SH[16 + e] * 256 + SH[8 + e] + rank; }
            __syncthreads();
            for (int q = tid; q < npair; q += 512) { const int pos = SH[320 + q]; TOKP[2 * r0 + q] = pos; }
            for (int q = 2 * wave; q < npair; q += 2 * NWAVES) { const int m = r0 + (q >> 1);
                const v4u* src = (const v4u*)(Hb + (size_t)m * D); v4u* d0 = (v4u*)(HPERM + (size_t)SH[320 + q] * D); v4u* d1 = (v4u*)(HPERM + (size_t)SH[320 + q + 1] * D);
                v4u t[4];
#pragma unroll
                for (int jj = 0; jj < 4; ++jj) t[jj] = src[lane + 64 * jj];
#pragma unroll
                for (int jj = 0; jj < 4; ++jj) { d0[lane + 64 * jj] = t[jj]; d1[lane + 64 * jj] = t[jj]; } }
            __syncthreads();
            conv_run(args.in[I_M1], args.in[I_M3], args.in[I_M2], MUP_T, MDN_T, ctl, MISC + 16, false, nullptr, 0u, 1 << 30);
        }
        if (layer == 1) SEAM(pb + 7);
        if (EN(9) && IN(pb + 8)) {
            int tz = threadIdx.x; asm volatile("" : "+v"(tz)); const int lane = tz & 63; const int wave = __builtin_amdgcn_readfirstlane(tz >> 6); const int tid = tz; const int gw = bx * NWAVES + wave; (void)lane; (void)tid; (void)gw;
            if (layer == 0) { const int gg = (G == 256) ? 235 : G;
                if (bx < gg) { pg8::Gemm g{Hb, FUP_T, M, 2 * FFD, D, 0}; pg8::StaticOrder S; S.init(M, 2 * FFD, gg, bx); pg8::EpiSwiglu E{GBUF, FFD, 0, 0}; pg8::gemm_phase(lds, g, S, E, tz, ctl + CW_DONE(2)); }
                else conv_run(args.in[I_M1], args.in[I_M3], args.in[I_M2], MUP_T, MDN_T, ctl, MISC + 16, true, ctl + CW_DONE(2), 16u, 1 << 30, 1); }
            else { const int nT = __builtin_amdgcn_readfirstlane(TILEE[127]);
                pg8::Gemm g{HPERM, MUP_T, nT * 256, 2 * FFE, D, (size_t)2 * FFE * D * 2}; pg8::MoeOrder S; S.init(nT, 2 * FFE, G, bx, TILEE); pg8::EpiSwiglu E{GBUF, FFE / 2, 28, (size_t)MAXPT * 256 * (FFE / 2)}; pg8::gemm_phase(lds, g, S, E, tz);
                __syncthreads();
                conv_run(args.in[I_M1], args.in[I_M3], args.in[I_M2], MUP_T, MDN_T, ctl, MISC + 16, true, nullptr, 0u, 1 << 30); }
        }
        SEAM(pb + 8);
        if (EN(10) && IN(pb + 9)) {
            int tz = threadIdx.x; asm volatile("" : "+v"(tz)); const int lane = tz & 63; const int wave = __builtin_amdgcn_readfirstlane(tz >> 6); const int tid = tz; const int gw = bx * NWAVES + wave; (void)lane; (void)tid; (void)gw;
            if (layer == 0) { pg8::Gemm g{GBUF, FDN_T, M, D, FFD, 0}; pg8::StaticOrder S; S.init(M, D, G, bx); pg8::EpiResid E{XA, XA}; pg8::gemm_phase(lds, g, S, E, tz); }
            else { const int nT = __builtin_amdgcn_readfirstlane(TILEE[127]);
                pg8::Gemm g{GBUF, MDN_T, 2 * MAXPT * 256, D, FFE / 2, (size_t)D * (FFE / 2) * 2}; pg8::MoeDownOrder S; S.init(nT, D, G, bx, TILEE); pg8::EpiMoeDown E{YPERM, HPERM}; pg8::gemm_phase(lds, g, S, E, tz); }
        }
        SEAM(pb + 9);
        if (EN(11) && IN(pb + 10)) {
            int tz = threadIdx.x; asm volatile("" : "+v"(tz)); const int lane = tz & 63; const int wave = __builtin_amdgcn_readfirstlane(tz >> 6); const int tid = tz; const int gw = bx * NWAVES + wave; (void)lane; (void)tid; (void)gw;
            if (layer == 0) { for (int m = gw; m < M; m += ngw) rms_row_to_bf16(XA + (size_t)m * D, args.in[I_NMIX] + D, Hb + (size_t)m * D, lane); }
            else {
                for (int m = gw; m < M; m += ngw) {
                    const int p0 = TOKP[2 * m], p1 = TOKP[2 * m + 1]; const float g0 = TOKW[2 * m], g1 = TOKW[2 * m + 1];
                    const f32x4* xr = (const f32x4*)(XA + (size_t)m * D) + lane; const v2u* y0 = (const v2u*)(YPERM + (size_t)p0 * D) + lane; const v2u* y1 = (const v2u*)(YPERM + (size_t)p1 * D) + lane;
                    const v2u* z0 = (const v2u*)(HPERM + (size_t)p0 * D) + lane; const v2u* z1 = (const v2u*)(HPERM + (size_t)p1 * D) + lane;
                    f32x4 v[8]; float s = 0.f;
#pragma unroll
                    for (int jj = 0; jj < 8; ++jj) { const v2u a = y0[64 * jj], c = y1[64 * jj], a2 = z0[64 * jj], c2 = z1[64 * jj]; f32x4 x = xr[64 * jj];
                        x.x += g0 * (bflo(a.x) + bflo(a2.x)) + g1 * (bflo(c.x) + bflo(c2.x)); x.y += g0 * (bfhi(a.x) + bfhi(a2.x)) + g1 * (bfhi(c.x) + bfhi(c2.x));
                        x.z += g0 * (bflo(a.y) + bflo(a2.y)) + g1 * (bflo(c.y) + bflo(c2.y)); x.w += g0 * (bfhi(a.y) + bfhi(a2.y)) + g1 * (bfhi(c.y) + bfhi(c2.y));
                        v[jj] = x; s += (x.x * x.x + x.y * x.y) + (x.z * x.z + x.w * x.w); }
                    const float rstd = 1.0f / sqrtf(wave_sum(s) * (1.0f / D) + EPS);
                    const f32x4* gr = (const f32x4*)args.in[I_NF] + lane; f32x4* orow = (f32x4*)(args.out + (size_t)m * D) + lane;
#pragma unroll
                    for (int jj = 0; jj < 8; ++jj) { const f32x4 gg = gr[64 * jj]; orow[64 * jj] = (f32x4){v[jj].x * rstd * gg.x, v[jj].y * rstd * gg.y, v[jj].z * rstd * gg.z, v[jj].w * rstd * gg.w}; }
                }
            }
        }
        SEAM(pb + 10);
    }
#undef IN
#undef SEAM
}

constexpr int N_PHASES = 23;
extern "C" void kernel_launch(void* const* d_in, const int* in_sizes, int n_in, void* d_out, int out_size, void* d_ws, size_t ws_size, hipStream_t stream) {
    static int grid = 0;
    if (grid == 0) {
        if (n_in != 26 || out_size != M * D || ws_size < WS_END) { fprintf(stderr, "kernel_launch: unexpected shapes: n_in %d out %d ws %zu (need %zu)\n", n_in, out_size, ws_size, (size_t)WS_END); grid = -1; return; }
        int dev = 0, cus = 0, per_cu = 0;
        if (hipGetDevice(&dev) != hipSuccess || hipDeviceGetAttribute(&cus, hipDeviceAttributeMultiprocessorCount, dev) != hipSuccess) { grid = -1; return; }
        if (hipFuncSetAttribute((const void*)trunk_fwd, hipFuncAttributeMaxDynamicSharedMemorySize, LDS_BYTES) != hipSuccess) { fprintf(stderr, "kernel_launch: hipFuncSetAttribute failed\n"); grid = -1; return; }
        if (hipOccupancyMaxActiveBlocksPerMultiprocessor(&per_cu, (const void*)trunk_fwd, NWAVES * 64, LDS_BYTES) != hipSuccess || per_cu < 1) { fprintf(stderr, "kernel_launch: occupancy query says %d\n", per_cu); }
        (void)hipGetLastError();
        grid = cus;
    }
    if (grid < 0) return;
    (void)hipMemsetAsync((char*)d_ws + WS_CTL, 0, 65536, stream);
    Args a{};
    for (int i = 0; i < 26; ++i) a.in[i] = (const float*)d_in[i];
    a.out = (float*)d_out; a.ws = (unsigned char*)d_ws;
#if MK_PER_PHASE
    for (int p = 0; p < N_PHASES; ++p) { a.ph_lo = p; a.ph_hi = p + 1; hipLaunchKernelGGL(trunk_fwd, dim3(grid), dim3(NWAVES * 64), LDS_BYTES, stream, a); }
#else
    a.ph_lo = 0; a.ph_hi = N_PHASES;
    hipLaunchKernelGGL(trunk_fwd, dim3(grid), dim3(NWAVES * 64), LDS_BYTES, stream, a);
#endif
}
```

```cpp
#include <hip/hip_runtime.h>
#include <cstdio>
#include <cstdint>

#ifndef MK_PER_PHASE
#define MK_PER_PHASE 0
#endif

#define GAS __attribute__((address_space(1)))
#define LAS __attribute__((address_space(3)))
typedef unsigned short bf16;
typedef unsigned short bf16_t;
typedef unsigned v4u __attribute__((ext_vector_type(4)));
typedef unsigned v2u __attribute__((ext_vector_type(2)));
typedef unsigned u32x4 __attribute__((ext_vector_type(4)));
typedef float f32x2 __attribute__((ext_vector_type(2)));
typedef float f32x4 __attribute__((ext_vector_type(4)));
typedef float f32x16 __attribute__((ext_vector_type(16)));
typedef short bf16x8 __attribute__((ext_vector_type(8)));

constexpr int NB = 4, T = 2048, M = NB * T, D = 2048;
constexpr int NHQ = 16, NG = 4, HD = 64;
constexpr int IN_W = 8752, ZLD = 8960;
constexpr int ZQ = 0, ZKS = 1536, ZVS = 1792, ZKW = 2048, ZVW = 2304, ZNG = 2560, ZU = 2816, ZV = 3840, ZGA = 4864, ZGB = 6912;
constexpr int FFD = 5632, FFE = 7168, NE = 8;
constexpr int MAXPT = 72;
constexpr float EPS = 1e-5f;
constexpr float LOG2E = 1.4426950408889634f;
constexpr float QSCALE = 0.125f * LOG2E;

constexpr size_t al256(size_t x) { return (x + 255) & ~(size_t)255; }
constexpr size_t WS_CTL = 0, CTL_BYTES = 1u << 20;
constexpr size_t WS_WIN = WS_CTL + CTL_BYTES;
constexpr size_t WS_CW1 = WS_WIN + (size_t)2 * ZLD * D * 2;
constexpr size_t WS_CW2 = WS_CW1 + (size_t)2 * 2 * 256 * 2048 * 2;
constexpr size_t WS_CB1 = WS_CW2 + (size_t)2 * 2 * 64 * 256 * 2;
constexpr size_t WS_WA = WS_CB1 + 4096;
constexpr size_t WS_WB = WS_WA + (size_t)2 * 2048 * 1024 * 2;
constexpr size_t WS_WO = WS_WB + (size_t)2 * 2048 * 1024 * 2;
constexpr size_t WS_SGW = WS_WO + (size_t)2 * 2048 * 2048 * 2;
constexpr size_t WS_FUP = WS_SGW + (size_t)2 * 8 * 128 * 128 * 2;
constexpr size_t WS_FDN = WS_FUP + (size_t)2 * FFD * D * 2;
constexpr size_t WS_MUP = WS_FDN + (size_t)D * FFD * 2;
constexpr size_t WS_MDN = WS_MUP + (size_t)NE * 2 * FFE * D * 2;
constexpr size_t WS_H = WS_MDN + (size_t)NE * D * FFE * 2;
constexpr size_t WS_XA = WS_H + (size_t)M * D * 2;
constexpr size_t WS_HPERM = WS_XA + (size_t)M * D * 4;
constexpr size_t WS_YPERM = WS_HPERM + (size_t)MAXPT * 256 * D * 2;
constexpr size_t WS_ROUTE = WS_YPERM + (size_t)MAXPT * 256 * D * 2;
constexpr size_t WS_KCT = WS_ROUTE + (1u << 20);
constexpr size_t WS_HID = WS_KCT + (size_t)2 * 16 * 128 * 64 * 2;
constexpr size_t WS_MIX = WS_HID + (size_t)4096 * 256 * 2;
constexpr size_t WS_Z = WS_MIX;
constexpr size_t WS_FLAT = WS_Z + (size_t)(M + 16) * ZLD * 2;
constexpr size_t WS_OA = WS_FLAT + (size_t)4096 * 2048 * 2;
constexpr size_t WS_OB = WS_OA + (size_t)M * 1024 * 2;
constexpr size_t WS_TMP = WS_OB + (size_t)M * 1024 * 2;
constexpr size_t WS_Y = WS_TMP + (size_t)M * D * 4;
constexpr size_t WS_MIX_END = WS_Y + (size_t)M * D * 2;
constexpr size_t WS_GBUF = WS_MIX;
constexpr size_t WS_GBUF_END = WS_GBUF + (size_t)MAXPT * 256 * FFE * 2;
constexpr size_t WS_END = WS_MIX_END > WS_GBUF_END ? WS_MIX_END : WS_GBUF_END;
constexpr size_t RT_TOKE = 0;
constexpr size_t RT_TOKW = 65536;
constexpr size_t RT_TOKP = 131072;
constexpr size_t RT_RGATE = 196608;
constexpr size_t RT_CNT = 294912;
constexpr size_t RT_TILEE = 327680;
constexpr int CW_BAR = 4096;

__device__ __forceinline__ unsigned f2bf(float f) { unsigned u = __builtin_bit_cast(unsigned, f); return (u + 0x7fffu + ((u >> 16) & 1u)) >> 16; }
__device__ __forceinline__ unsigned pk2(float lo, float hi) { return f2bf(lo) | (f2bf(hi) << 16); }
__device__ __forceinline__ float bf2f(unsigned short b) { return __builtin_bit_cast(float, ((unsigned)b) << 16); }
__device__ __forceinline__ float bflo(unsigned w) { return __builtin_bit_cast(float, w << 16); }
__device__ __forceinline__ float bfhi(unsigned w) { return __builtin_bit_cast(float, w & 0xffff0000u); }
typedef float f32x2_t __attribute__((ext_vector_type(2))); typedef __bf16 bf16x2_t __attribute__((ext_vector_type(2)));
__device__ __forceinline__ unsigned cvt_pk_bf16(float lo, float hi) { f32x2_t v = {lo, hi}; bf16x2_t b = __builtin_convertvector(v, bf16x2_t); return __builtin_bit_cast(unsigned, b); }
__device__ __forceinline__ float wave_sum(float v) {
#pragma unroll
    for (int o = 1; o < 64; o <<= 1) v += __shfl_xor(v, o);
    return v;
}
__device__ __forceinline__ float sigmoidf_(float x) { return __builtin_amdgcn_rcpf(1.0f + __builtin_amdgcn_exp2f(-LOG2E * x)); }
__device__ __forceinline__ float siluf_(float x) { return x * sigmoidf_(x); }
__device__ __forceinline__ float geluf_(float x) { return x * __builtin_amdgcn_rcpf(1.0f + __builtin_amdgcn_exp2f(-2.3022082f * (x + 0.044715f * x * x * x))); }
__device__ __forceinline__ int crow(int r, int hi) { return (r & 3) + 8 * (r >> 2) + 4 * hi; }
#define MFMA32(a, b, c) __builtin_amdgcn_mfma_f32_32x32x16_bf16((a), (b), (c), 0, 0, 0)

namespace pg8 {
constexpr int BM = 256, BK = 64, HALF = 128, HTB = HALF * BK * 2, STAGE_BYTES = 8 * HTB, NXCD = 8, WGM = 8;
__host__ __device__ __forceinline__ int lds_byte(int r, int c) { const int st = (r >> 4) * 2 + (c >> 5), rr = r & 15, cc = c & 31, ob = rr * 64 + cc * 2; return st * 1024 + (ob ^ (((ob >> 9) & 1) << 5)); }
__host__ __device__ __forceinline__ void stage_rc(int b, int& R, int& C) { const int st = b / 1024, sb = b % 1024, swz = sb ^ (((sb >> 9) & 1) << 5); R = (st >> 1) * 16 + swz / 64; C = (st & 1) * 32 + (swz % 64) / 2; }
__host__ __device__ __forceinline__ int perm32(int rho) { const int n = rho >> 4, i = rho & 15; return 8 * (i >> 2) + 4 * n + (i & 3); }

struct Unit { int pm, pn, be; };
struct Gemm { const bf16_t* A; const bf16_t* Bt; int M, N, K; size_t bstride; };

__device__ __forceinline__ void static_map(int wgid, int nM, int nN, int& pm, int& pn) {
    const int nwg = nM * nN;
    { const int q = nwg / NXCD, r = nwg % NXCD, xcd = wgid % NXCD, off = wgid / NXCD; wgid = (xcd < r ? xcd * (q + 1) : r * (q + 1) + (xcd - r) * q) + off; }
    const int nig = WGM * nN, gid = wgid / nig, fm = gid * WGM, gsz = (nM - fm) < WGM ? (nM - fm) : WGM;
    pm = fm + ((wgid % nig) % gsz); pn = (wgid % nig) / gsz;
}
struct StaticOrder {
    int nM, nN, nwg, G, c, be;
    __device__ void init(int M_, int N_, int G_, int c_, int be_ = 0) { nM = M_ / BM; nN = N_ / BM; nwg = nM * nN; G = G_; c = c_; be = be_; }
    __device__ bool next(int i, Unit& u) const {
        const long L = (long)i * G + c; if (L >= nwg) return false;
        static_map((int)L, nM, nN, u.pm, u.pn); u.be = be; return true;
    }
};
struct CmpOrder {
    int c;
    __device__ bool next(int i, Unit& u) const { if (i > 0 || c >= 16) return false; u.pm = c; u.pn = 0; u.be = c >> 3; return true; }
};
struct MoeOrder {
    int nM, nN, nwg, G, c; const int* tile_e;
    __device__ void init(int nM_, int N_, int G_, int c_, const int* te) { nM = nM_; nN = N_ / BM; nwg = nM * nN; G = G_; c = c_; tile_e = te; }
    __device__ bool next(int i, Unit& u) const {
        const long L = (long)i * G + c; if (L >= nwg) return false;
        static_map((int)L, nM, nN, u.pm, u.pn); u.be = __builtin_amdgcn_readfirstlane(tile_e[u.pm]); return true;
    }
};

struct MoeDownOrder {
    int nT, nV, nN, nwg, G, c; const int* tile_e;
    __device__ void init(int nT_, int N_, int G_, int c_, const int* te) { nT = nT_; nV = 2 * nT_; nN = N_ / BM; nwg = nV * nN; G = G_; c = c_; tile_e = te; }
    __device__ bool next(int i, Unit& u) const {
        const long L = (long)i * G + c; if (L >= nwg) return false;
        int v, pn; static_map((int)L, nV, nN, v, pn); const int h = v >= nT ? 1 : 0, t = v - h * nT;
        u.pm = h * MAXPT + t; u.pn = pn; u.be = __builtin_amdgcn_readfirstlane(tile_e[t]) * 2 + h; return true;
    }
};
template <class Epi, class Sched>
__device__ __forceinline__ void gemm_phase(LAS unsigned char* lds, const Gemm g, const Sched& S, const Epi& E, const int tid, unsigned* last_sig = nullptr) {
    const int wid = __builtin_amdgcn_readfirstlane(tid >> 6), lane = tid & 63, wr = wid >> 2, wc = wid & 3, fr = lane & 15, fq = lane >> 4;
    const int K = g.K, nt = K / BK;
    unsigned voffA[2], voffB[2];
#pragma unroll
    for (int i = 0; i < 2; ++i) { int R, C; stage_rc(tid * 16 + i * 8192, R, C); const int Rb = Epi::PERM ? ((R & ~31) + perm32(R & 31)) : R;
        voffA[i] = (unsigned)(R * K + C) * 2u; voffB[i] = (unsigned)(Rb * K + C) * 2u; }
    const size_t kstep = (size_t)(BK * 2);
    const size_t hstep = (size_t)HALF * K * 2;
    const size_t tstep = 2 * hstep;
    const unsigned ldsw = (unsigned)wid * 1024u;
    const int aoff = lds_byte(wr * 64 + fr, fq * 8), boff = lds_byte(wc * 32 + fr, fq * 8);
#define PG8_SA(b, h) (((b) * 2 + (h)) * HTB)
#define PG8_SB(b, h) ((4 + (b) * 2 + (h)) * HTB)
#define PG8_STAGE(bufoff, gbase, voff) do { _Pragma("unroll") for (int _i = 0; _i < 2; ++_i) \
        __builtin_amdgcn_global_load_lds((const unsigned*)((const char*)(gbase) + (voff)[_i]), (LAS unsigned*)(lds + (bufoff) + ldsw + _i * 8192), 16, 0, 0); } while (0)
#define PG8_LDA(dst, b, h) do { _Pragma("unroll") for (int m = 0; m < 4; ++m) _Pragma("unroll") for (int k = 0; k < 2; ++k) dst[m][k] = *(const LAS bf16x8*)(lds + PG8_SA(b, h) + aoff + m * 2048 + k * 1024); } while (0)
#define PG8_LDB(dst, b, h) do { _Pragma("unroll") for (int n = 0; n < 2; ++n) _Pragma("unroll") for (int k = 0; k < 2; ++k) dst[n][k] = *(const LAS bf16x8*)(lds + PG8_SB(b, h) + boff + n * 2048 + k * 1024); } while (0)
#define PG8_MMA(ai, bj, At, Bt) do { __builtin_amdgcn_s_setprio(1); _Pragma("unroll") for (int m = 0; m < 4; ++m) _Pragma("unroll") for (int n = 0; n < 2; ++n) _Pragma("unroll") for (int k = 0; k < 2; ++k) \
        acc[ai][bj][m][n] = __builtin_amdgcn_mfma_f32_16x16x32_bf16(Bt[n][k], At[m][k], acc[ai][bj][m][n], 0, 0, 0); __builtin_amdgcn_s_setprio(0); } while (0)
#define PG8_WAIT_V(n) asm volatile("s_waitcnt vmcnt(" #n ")" ::: "memory")
#define PG8_WAIT_L(n) asm volatile("s_waitcnt lgkmcnt(" #n ")" ::: "memory")
#define PG8_BAR __builtin_amdgcn_s_barrier()
#define PG8_SCHED __builtin_amdgcn_sched_barrier(0)
    Unit cur, nxt; int ui = 0;
    if (!S.next(0, cur)) return;
    f32x4 acc[2][2][4][2];
#pragma unroll
    for (int a = 0; a < 2; ++a)
#pragma unroll
        for (int b = 0; b < 2; ++b)
#pragma unroll
            for (int m = 0; m < 4; ++m)
#pragma unroll
                for (int n = 0; n < 2; ++n) acc[a][b][m][n] = (f32x4){0.f, 0.f, 0.f, 0.f};
    bf16x8 At[4][2], B0[2][2], B1[2][2];
    const char* cA = (const char*)g.A + (size_t)cur.pm * tstep; const char* cB = (const char*)g.Bt + (size_t)cur.be * g.bstride + (size_t)cur.pn * tstep;
    PG8_STAGE(PG8_SB(0, 0), cB, voffB); PG8_STAGE(PG8_SB(0, 1), cB + hstep, voffB); PG8_STAGE(PG8_SA(0, 0), cA, voffA); PG8_STAGE(PG8_SA(0, 1), cA + hstep, voffA);
    if (wr == 1) PG8_BAR;
    PG8_WAIT_V(2); PG8_BAR;
    PG8_STAGE(PG8_SB(1, 0), cB + kstep, voffB); PG8_STAGE(PG8_SA(1, 0), cA + kstep, voffA); PG8_STAGE(PG8_SB(1, 1), cB + hstep + kstep, voffB);
    PG8_WAIT_V(6); PG8_BAR;
    for (;;) {
        const bool has_next = S.next(ui + 1, nxt);
        if (last_sig != nullptr && !has_next && wid == 0 && __builtin_amdgcn_mbcnt_hi(~0u, __builtin_amdgcn_mbcnt_lo(~0u, 0u)) == 0u) (void)__hip_atomic_fetch_add(last_sig, 1u, __ATOMIC_RELAXED, __HIP_MEMORY_SCOPE_AGENT);
        const char* nA = has_next ? (const char*)g.A + (size_t)nxt.pm * tstep : cA; const char* nB = has_next ? (const char*)g.Bt + (size_t)nxt.be * g.bstride + (size_t)nxt.pn * tstep : cB;
        for (int t = 0; t < nt; t += 2) {
            const bool last = (t == nt - 2);
            const char* a1 = cA + (size_t)(t + 1) * kstep;
            const char* a2 = last ? nA : cA + (size_t)(t + 2) * kstep; const char* b2 = last ? nB : cB + (size_t)(t + 2) * kstep;
            const char* a3 = a2 + kstep; const char* b3 = b2 + kstep;
            PG8_LDB(B0, 0, 0); PG8_LDB(B1, 0, 1); PG8_SCHED; PG8_LDA(At, 0, 0); PG8_STAGE(PG8_SA(1, 1), a1 + hstep, voffA);
            PG8_WAIT_V(8); PG8_WAIT_L(0); PG8_BAR; PG8_MMA(0, 0, At, B0); PG8_MMA(0, 1, At, B1); PG8_BAR; PG8_SCHED;
            PG8_LDA(At, 0, 1); PG8_STAGE(PG8_SB(0, 0), b2, voffB); PG8_STAGE(PG8_SB(0, 1), b2 + hstep, voffB); PG8_STAGE(PG8_SA(0, 0), a2, voffA);
            PG8_WAIT_V(8); PG8_WAIT_L(0); PG8_BAR; PG8_MMA(1, 0, At, B0); PG8_MMA(1, 1, At, B1); PG8_BAR; PG8_SCHED;
            PG8_LDB(B0, 1, 0); PG8_LDB(B1, 1, 1); PG8_SCHED; PG8_LDA(At, 1, 0); PG8_STAGE(PG8_SA(0, 1), a2 + hstep, voffA);
            PG8_WAIT_V(8); PG8_WAIT_L(0); PG8_BAR; PG8_MMA(0, 0, At, B0); PG8_MMA(0, 1, At, B1); PG8_BAR; PG8_SCHED;
            PG8_LDA(At, 1, 1); PG8_STAGE(PG8_SB(1, 0), b3, voffB); PG8_STAGE(PG8_SB(1, 1), b3 + hstep, voffB); PG8_STAGE(PG8_SA(1, 0), a3, voffA);
            PG8_WAIT_V(8); PG8_WAIT_L(0); PG8_BAR; PG8_MMA(1, 0, At, B0); PG8_MMA(1, 1, At, B1); PG8_BAR; PG8_SCHED;
        }
        if (wr == 0) PG8_BAR;
        E(acc, cur, wr, wc, fr, fq);
        if (!has_next) break;
#pragma unroll
        for (int a = 0; a < 2; ++a)
#pragma unroll
            for (int b = 0; b < 2; ++b)
#pragma unroll
                for (int m = 0; m < 4; ++m)
#pragma unroll
                    for (int n = 0; n < 2; ++n) acc[a][b][m][n] = (f32x4){0.f, 0.f, 0.f, 0.f};
        cur = nxt; cA = nA; cB = nB; ++ui;
        if (wr == 1) PG8_BAR;
    }
    PG8_WAIT_V(0);
    PG8_BAR;
#undef PG8_SA
#undef PG8_SB
#undef PG8_STAGE
#undef PG8_LDA
#undef PG8_LDB
#undef PG8_MMA
#undef PG8_WAIT_V
#undef PG8_WAIT_L
#undef PG8_BAR
#undef PG8_SCHED
}

struct EpiWin {
    static constexpr bool PERM = true;
    bf16_t* Z; bf16_t* flat;
    template <int KIND> __device__ __forceinline__ void run(const f32x4 (&acc)[2][2][4][2], const Unit& u, int wr, int wc, int fr, int fq) const {
        const int row0 = u.pm * BM + wr * 64 + fr, colin = wc * 32 + 8 * fq;
#pragma unroll
        for (int ai = 0; ai < 2; ++ai)
#pragma unroll
            for (int m = 0; m < 4; ++m) { const int row = row0 + ai * HALF + m * 16;
#pragma unroll
                for (int bj = 0; bj < 2; ++bj) { f32x4 v0 = acc[ai][bj][m][0], v1 = acc[ai][bj][m][1];
                    if (KIND == 1) { v0 = v0 * QSCALE; v1 = v1 * QSCALE; }
                    if (KIND == 2) {
#pragma unroll
                        for (int j = 0; j < 4; ++j) { v0[j] = geluf_(v0[j]); v1[j] = geluf_(v1[j]); } }
                    if (KIND == 3) {
#pragma unroll
                        for (int j = 0; j < 4; ++j) { v0[j] = sigmoidf_(v0[j]); v1[j] = sigmoidf_(v1[j]); } }
                    u32x4 w; w.x = cvt_pk_bf16(v0[0], v0[1]); w.y = cvt_pk_bf16(v0[2], v0[3]); w.z = cvt_pk_bf16(v1[0], v1[1]); w.w = cvt_pk_bf16(v1[2], v1[3]);
                    const int cc = bj * HALF + colin;
                    if (KIND == 4) {
                        const int b = row >> 11, tt = row & 2047, j = tt >> 4, pp = tt & 15, gg = cc >> 6, d = cc & 63;
                        bf16_t* fl = flat + (size_t)(u.pn - 4) * 2048 * 2048;
                        *(u32x4*)(fl + (size_t)((b * 128 + j) * 4 + gg) * 2048 + pp * 64 + d) = w;
                        if (j >= 1) *(u32x4*)(fl + (size_t)((b * 128 + j - 1) * 4 + gg) * 2048 + (16 + pp) * 64 + d) = w;
                    } else {
                        *(u32x4*)(Z + (size_t)row * ZLD + u.pn * BM + cc) = w;
                    } } }
    }
    __device__ __forceinline__ void operator()(const f32x4 (&acc)[2][2][4][2], const Unit& u, int wr, int wc, int fr, int fq) const {
        const int pn = u.pn;
        if (pn < 4) run<1>(acc, u, wr, wc, fr, fq);
        else if (pn < 6) run<4>(acc, u, wr, wc, fr, fq);
        else if (pn < 11) run<0>(acc, u, wr, wc, fr, fq);
        else if (pn < 19) run<2>(acc, u, wr, wc, fr, fq);
        else run<3>(acc, u, wr, wc, fr, fq);
    }
};
struct EpiCmp {
    static constexpr bool PERM = true;
    bf16_t* O; const float* bias;
    __device__ __forceinline__ void operator()(const f32x4 (&acc)[2][2][4][2], const Unit& u, int wr, int wc, int fr, int fq) const {
        const int row0 = u.pm * BM + wr * 64 + fr, colin = wc * 32 + 8 * fq;
        f32x4 bv[2][2];
#pragma unroll
        for (int bj = 0; bj < 2; ++bj)
#pragma unroll
            for (int n = 0; n < 2; ++n) bv[bj][n] = *(const f32x4*)(bias + u.be * 256 + colin + bj * HALF + 4 * n);
#pragma unroll
        for (int ai = 0; ai < 2; ++ai)
#pragma unroll
            for (int m = 0; m < 4; ++m) { bf16_t* rowp = O + (size_t)(row0 + ai * HALF + m * 16) * 256 + colin;
#pragma unroll
                for (int bj = 0; bj < 2; ++bj) { f32x4 v0 = acc[ai][bj][m][0] + bv[bj][0], v1 = acc[ai][bj][m][1] + bv[bj][1];
#pragma unroll
                    for (int j = 0; j < 4; ++j) { v0[j] = geluf_(v0[j]); v1[j] = geluf_(v1[j]); }
                    u32x4 w; w.x = cvt_pk_bf16(v0[0], v0[1]); w.y = cvt_pk_bf16(v0[2], v0[3]); w.z = cvt_pk_bf16(v1[0], v1[1]); w.w = cvt_pk_bf16(v1[2], v1[3]);
                    *(u32x4*)(rowp + bj * HALF) = w; } }
    }
};
struct EpiGate {
    static constexpr bool PERM = true;
    const bf16_t* Z; bf16_t* tmp; bf16_t* Y;
    __device__ __forceinline__ void operator()(const f32x4 (&acc)[2][2][4][2], const Unit& u, int wr, int wc, int fr, int fq) const {
        const int row0 = u.pm * BM + wr * 64 + fr, col0 = u.pn * BM + wc * 32 + 8 * fq;
        const int goff = u.be ? ZGB : ZGA;
#pragma unroll
        for (int ai = 0; ai < 2; ++ai) {
            u32x4 gq[4][2], tq[4][2];
#pragma unroll
            for (int m = 0; m < 4; ++m) { const size_t row = (size_t)(row0 + ai * HALF + m * 16);
#pragma unroll
                for (int bj = 0; bj < 2; ++bj) { const int c = col0 + bj * HALF;
                    gq[m][bj] = *(const u32x4*)(Z + row * ZLD + goff + c);
                    if (u.be != 0) tq[m][bj] = *(const u32x4*)(tmp + row * D + c); } }
#pragma unroll
            for (int m = 0; m < 4; ++m) { const size_t row = (size_t)(row0 + ai * HALF + m * 16);
#pragma unroll
                for (int bj = 0; bj < 2; ++bj) { const int c = col0 + bj * HALF; const u32x4 g = gq[m][bj];
                    f32x4 v0 = acc[ai][bj][m][0] * (f32x4){bflo(g.x), bfhi(g.x), bflo(g.y), bfhi(g.y)};
                    f32x4 v1 = acc[ai][bj][m][1] * (f32x4){bflo(g.z), bfhi(g.z), bflo(g.w), bfhi(g.w)};
                    if (u.be != 0) { const u32x4 t = tq[m][bj];
                        v0 = v0 + (f32x4){bflo(t.x), bfhi(t.x), bflo(t.y), bfhi(t.y)}; v1 = v1 + (f32x4){bflo(t.z), bfhi(t.z), bflo(t.w), bfhi(t.w)}; }
                    u32x4 w; w.x = cvt_pk_bf16(v0[0], v0[1]); w.y = cvt_pk_bf16(v0[2], v0[3]); w.z = cvt_pk_bf16(v1[0], v1[1]); w.w = cvt_pk_bf16(v1[2], v1[3]);
                    *(u32x4*)((u.be != 0 ? Y : tmp) + row * D + c) = w; } }
        }
    }
};
struct EpiResid {
    static constexpr bool PERM = false;
    const float* base; float* out;
    __device__ __forceinline__ void operator()(const f32x4 (&acc)[2][2][4][2], const Unit& u, int wr, int wc, int fr, int fq) const {
        const int row0 = u.pm * BM + wr * 64 + fr, col0 = u.pn * BM + wc * 32 + 4 * fq;
#pragma unroll
        for (int ai = 0; ai < 2; ++ai) {
            f32x4 bs[4][2][2];
#pragma unroll
            for (int m = 0; m < 4; ++m) { const size_t off = (size_t)(row0 + ai * HALF + m * 16) * D + col0;
#pragma unroll
                for (int bj = 0; bj < 2; ++bj)
#pragma unroll
                    for (int n = 0; n < 2; ++n) bs[m][bj][n] = *(const f32x4*)(base + off + bj * HALF + n * 16); }
#pragma unroll
            for (int m = 0; m < 4; ++m) { const size_t off = (size_t)(row0 + ai * HALF + m * 16) * D + col0;
#pragma unroll
                for (int bj = 0; bj < 2; ++bj)
#pragma unroll
                    for (int n = 0; n < 2; ++n) *(f32x4*)(out + off + bj * HALF + n * 16) = bs[m][bj][n] + acc[ai][bj][m][n]; }
        }
    }
};
struct EpiSwiglu {
    static constexpr bool PERM = true;
    bf16_t* Gb; int ldg; int half_tiles; size_t half_stride;
    __device__ __forceinline__ void operator()(const f32x4 (&acc)[2][2][4][2], const Unit& u, int wr, int wc, int fr, int fq) const {
        const int hsel = (half_tiles > 0 && u.pn >= half_tiles) ? 1 : 0;
        const int row0 = u.pm * BM + wr * 64 + fr, col0 = (u.pn - hsel * half_tiles) * HALF + wc * 32 + 8 * fq;
        bf16_t* const Gh = Gb + (size_t)hsel * half_stride;
#pragma unroll
        for (int ai = 0; ai < 2; ++ai)
#pragma unroll
            for (int m = 0; m < 4; ++m) { bf16_t* rowp = Gh + (size_t)(row0 + ai * HALF + m * 16) * ldg + col0;
                f32x4 a0 = acc[ai][0][m][0], a1 = acc[ai][0][m][1]; const f32x4 b0 = acc[ai][1][m][0], b1 = acc[ai][1][m][1];
#pragma unroll
                for (int j = 0; j < 4; ++j) { a0[j] = siluf_(a0[j]) * b0[j]; a1[j] = siluf_(a1[j]) * b1[j]; }
                u32x4 w; w.x = cvt_pk_bf16(a0[0], a0[1]); w.y = cvt_pk_bf16(a0[2], a0[3]); w.z = cvt_pk_bf16(a1[0], a1[1]); w.w = cvt_pk_bf16(a1[2], a1[3]);
                *(u32x4*)rowp = w; }
    }
};
struct EpiMoeDown {
    static constexpr bool PERM = true;
    bf16_t* Y0; bf16_t* Y1;
    __device__ __forceinline__ void operator()(const f32x4 (&acc)[2][2][4][2], const Unit& u, int wr, int wc, int fr, int fq) const {
        const int hsel = u.pm >= MAXPT ? 1 : 0; bf16_t* const Y = hsel ? Y1 : Y0;
        const int row0 = (u.pm - hsel * MAXPT) * BM + wr * 64 + fr, col0 = u.pn * BM + wc * 32 + 8 * fq;
#pragma unroll
        for (int ai = 0; ai < 2; ++ai)
#pragma unroll
            for (int m = 0; m < 4; ++m) { const int row = row0 + ai * HALF + m * 16; bf16_t* rowp = Y + (size_t)row * D + col0;
#pragma unroll
                for (int bj = 0; bj < 2; ++bj) { const f32x4 v0 = acc[ai][bj][m][0], v1 = acc[ai][bj][m][1];
                    u32x4 w; w.x = cvt_pk_bf16(v0[0], v0[1]); w.y = cvt_pk_bf16(v0[2], v0[3]); w.z = cvt_pk_bf16(v1[0], v1[1]); w.w = cvt_pk_bf16(v1[2], v1[3]);
                    *(u32x4*)(rowp + bj * HALF) = w; } }
    }
};
}

#define XB_TMO      128
#define XB_XCNT(j)  (256  + 64 * (j))
#define XB_XSUB(j)  (1280 + 64 * (j))
#define XB_XGEN(j)  (2304 + 64 * (j))
#define XB_TOP      3328
#define XB_TOPGEN   3392
#define XCD_BAR_WORDS 3456
#define XB_SPIN_CAP (1u << 18)
__device__ __forceinline__ unsigned xb_ld(unsigned* p)              { return __hip_atomic_load(p, __ATOMIC_RELAXED, __HIP_MEMORY_SCOPE_AGENT); }
__device__ __forceinline__ unsigned xb_add(unsigned* p, unsigned v) { return __hip_atomic_fetch_add(p, v, __ATOMIC_RELAXED, __HIP_MEMORY_SCOPE_AGENT); }
__device__ __forceinline__ unsigned xb_xcc_id() { return (unsigned)__builtin_amdgcn_s_getreg((3 << 11) | 20) & 0xFu; }
#define XB_SPIN(cond, bar) do { unsigned _sp = 0; while (cond) { __builtin_amdgcn_s_sleep(1); \
    if ((++_sp & 255u) == 0u) { if (xb_ld(&(bar)[XB_TMO])) break; if (_sp > XB_SPIN_CAP) { atomicAdd(&(bar)[XB_TMO], 1u); break; } } } } while (0)
struct XcdBarrier { unsigned* bar; unsigned x; volatile LAS unsigned* st; };
__device__ __forceinline__ XcdBarrier xcd_barrier_post(unsigned* bar, volatile LAS unsigned* st) {
    XcdBarrier b; b.bar = bar; b.x = xb_xcc_id(); b.st = st;
    if (threadIdx.x == 0) (void)xb_add(&bar[XB_XCNT(b.x)], 1u);
    return b;
}
__device__ __forceinline__ void xcd_barrier_complete(unsigned* bar, unsigned x, unsigned& nloc, unsigned& nx) {
    const unsigned G = gridDim.x * gridDim.y * gridDim.z;
    unsigned sum, cnt, mine, sp = 0u;
    for (;;) {
        sum = 0u; cnt = 0u; mine = 0u;
#pragma unroll
        for (unsigned j = 0; j < 16; ++j) { const unsigned c = xb_ld(&bar[XB_XCNT(j)]); sum += c; cnt += (c > 0u) ? 1u : 0u; mine = (j == x) ? c : mine; }
        if (sum == G) break;
        __builtin_amdgcn_s_sleep(1);
        if ((++sp & 255u) == 0u) { if (xb_ld(&bar[XB_TMO])) break; if (sp > XB_SPIN_CAP) { atomicAdd(&bar[XB_TMO], 1u); break; } }
    }
    nloc = mine > 0u ? mine : 1u; nx = cnt > 0u ? cnt : 1u;
}
__device__ __forceinline__ void xcd_barrier(const XcdBarrier& b) {
    asm volatile("s_waitcnt vmcnt(0)" ::: "memory");
    __syncthreads();
    if (threadIdx.x == 0) {
        unsigned* bar = b.bar;
        __builtin_amdgcn_s_waitcnt(0);
        unsigned nloc = b.st[0], nx = b.st[1];
        if (nloc == 0u) { xcd_barrier_complete(bar, b.x, nloc, nx); b.st[0] = nloc; b.st[1] = nx; }
        const unsigned old = xb_add(&bar[XB_XSUB(b.x)], 1u);
        const unsigned gen = old / nloc;
        if (old + 1u == (gen + 1u) * nloc) {
            __builtin_amdgcn_fence(__ATOMIC_RELEASE, "agent");
            asm volatile("s_waitcnt vmcnt(0)" ::: "memory");
            const unsigned og = xb_add(&bar[XB_TOP], 1u);
            const unsigned tg = og / nx;
            if (og + 1u == (tg + 1u) * nx) xb_add(&bar[XB_TOPGEN], 1u);
            else XB_SPIN(xb_ld(&bar[XB_TOPGEN]) == tg, bar);
            __builtin_amdgcn_fence(__ATOMIC_ACQUIRE, "agent");
            xb_add(&bar[XB_XGEN(b.x)], 1u);
            asm volatile("s_waitcnt vmcnt(0)" ::: "memory");
        } else {
            XB_SPIN(xb_ld(&bar[XB_XGEN(b.x)]) == gen, bar);
            __builtin_amdgcn_fence(__ATOMIC_ACQUIRE, "agent");
            asm volatile("s_waitcnt vmcnt(0)" ::: "memory");
        }
    }
    __syncthreads();
}

struct Args {
    const float* in[26];
    float* out; unsigned char* ws;
    int ph_lo, ph_hi;
};
enum { I_X = 0, I_NMIX, I_WIN, I_PEK, I_PEV, I_KW1, I_KW2, I_VW1, I_VW2, I_LNG, I_LNB, I_SGW, I_SGB, I_WA, I_WB, I_WO, I_NFFN, I_F1, I_F3, I_F2, I_RW, I_RB, I_M1, I_M3, I_M2, I_NF };

constexpr int NWAVES = 8;
constexpr int LDS_BYTES = 147456;
constexpr int LDS_MISC = 131072;

__device__ __forceinline__ void conv_item(const float* W, size_t ldw, int scol0, int nvalid, bf16* WT, int K, int drow0, int k0, LAS float* scr, int lane) {
    const int nl = lane & 31; const bool ok = nl < nvalid;
#pragma unroll 8
    for (int i = 0; i < 32; ++i) { const int kk = 2 * i + (lane >> 5); scr[kk * 33 + nl] = ok ? W[(size_t)(k0 + kk) * ldw + scol0 + nl] : 0.f; }
    asm volatile("s_waitcnt lgkmcnt(0)" ::: "memory");
    const int c = lane & 7;
#pragma unroll
    for (int j = 0; j < 4; ++j) { const int n = (lane >> 3) + 8 * j; const LAS float* s = scr + (8 * c) * 33 + n;
        v4u o; o.x = pk2(s[0 * 33], s[1 * 33]); o.y = pk2(s[2 * 33], s[3 * 33]); o.z = pk2(s[4 * 33], s[5 * 33]); o.w = pk2(s[6 * 33], s[7 * 33]);
        *(v4u*)(WT + (size_t)(drow0 + n) * K + k0 + 8 * c) = o; }
    asm volatile("s_waitcnt lgkmcnt(0)" ::: "memory");
}
__device__ __forceinline__ void conv_plain(const float* W, size_t ldw, int K, int N, bf16* WT, LAS float* scr, int gw, int ngw, int lane) {
    const int nblk = N / 32, items = (K / 64) * nblk;
    for (int it = gw; it < items; it += ngw) { const int kb = it / nblk, nb = it % nblk; conv_item(W, ldw, nb * 32, 32, WT, K, nb * 32, kb * 64, scr, lane); }
}
__device__ __forceinline__ void conv_win(const float* W, bf16* WT, LAS float* scr, int gw, int ngw, int lane) {
    const int nblk = ZLD / 32, items = (D / 64) * nblk;
    for (int it = gw; it < items; it += ngw) { const int kb = it / nblk, nb = it % nblk, d0 = nb * 32;
        int scol, nv; if (d0 + 32 <= 2608) { scol = d0; nv = 32; } else if (d0 < 2608) { scol = d0; nv = 2608 - d0; } else if (d0 < 2816) { scol = 0; nv = 0; } else { scol = d0 - 208; nv = 32; }
        conv_item(W, IN_W, scol, nv, WT, D, d0, kb * 64, scr, lane); }
}
__device__ __forceinline__ void conv_up(const float* W1, const float* W3, int F, bf16* WT, LAS float* scr, int gw, int ngw, int lane) {
    const int nblk = 2 * F / 32, items = (D / 64) * nblk;
    for (int it = gw; it < items; it += ngw) { const int kb = it / nblk, nb = it % nblk, d0 = nb * 32, pn = d0 >> 8, within = d0 & 255;
        const float* W = within < 128 ? W1 : W3; const int scol = pn * 128 + (within & 127);
        conv_item(W, F, scol, 32, WT, D, d0, kb * 64, scr, lane); }
}

__device__ __forceinline__ void conv_tile(const float* W, int ldw, int K, int N, bf16* WT, int rowmode, int kb, int nb, int lane, int sb0 = 0, int sb1 = 8) {
    const int c = lane & 7, nn = lane >> 3;
    const float* src0 = W + (size_t)(kb * 64 + 8 * c) * ldw;
#pragma unroll 2
    for (int sb = sb0; sb < sb1; ++sb) {
        const int n = nb * 256 + sb * 32 + 4 * nn;
        if (n < N) {
            int r = n;
            if (rowmode == 1) r = n < 2608 ? n : n + 208;
            else if (rowmode == 2) r = ((n >> 7) << 8) + (n & 127);
            else if (rowmode == 3) r = ((n >> 7) << 8) + 128 + (n & 127);
            const float* src = src0 + n;
            f32x4 v[8];
#pragma unroll
            for (int i = 0; i < 8; ++i) v[i] = *(const f32x4*)(src + (size_t)i * ldw);
            bf16* d0 = WT + (size_t)r * K + kb * 64 + 8 * c;
#pragma unroll
            for (int j = 0; j < 4; ++j) { u32x4 o; o.x = cvt_pk_bf16(v[0][j], v[1][j]); o.y = cvt_pk_bf16(v[2][j], v[3][j]); o.z = cvt_pk_bf16(v[4][j], v[5][j]); o.w = cvt_pk_bf16(v[6][j], v[7][j]);
                *(u32x4*)(d0 + (size_t)j * K) = o; }
        }
    }
}
constexpr int CQ_M13 = 8 * 2 * 32 * 7, CQ_M2 = 8 * 112 * 2;
constexpr int CW_Q = 8192;
#define CW_DONE(i) (CW_Q + 64 + 32 * (i))
constexpr unsigned CQ_END = 0xFFFFFFFFu;
__device__ __forceinline__ void conv_span128(const float* W, int ldw, int K, bf16* WT, int rowmode, int kb, int n0, int lane) {
    const int c = lane & 7, nn = lane >> 3;
    const float* src = W + (size_t)(kb * 64 + 8 * c) * ldw + n0 + 4 * nn;
    f32x4 v[4][8];
#pragma unroll
    for (int h = 0; h < 4; ++h)
#pragma unroll
        for (int i = 0; i < 8; ++i) v[h][i] = __builtin_nontemporal_load((const f32x4*)(src + 32 * h + (size_t)i * ldw));
#pragma unroll
    for (int h = 0; h < 4; ++h) {
        const int n = n0 + 32 * h + 4 * nn; int r = n;
        if (rowmode == 2) r = ((n >> 7) << 8) + (n & 127);
        else if (rowmode == 3) r = ((n >> 7) << 8) + 128 + (n & 127);
        bf16* d0 = WT + (size_t)r * K + kb * 64 + 8 * c;
#pragma unroll
        for (int j = 0; j < 4; ++j) { u32x4 o; o.x = cvt_pk_bf16(v[h][0][j], v[h][1][j]); o.y = cvt_pk_bf16(v[h][2][j], v[h][3][j]); o.z = cvt_pk_bf16(v[h][4][j], v[h][5][j]); o.w = cvt_pk_bf16(v[h][6][j], v[h][7][j]);
            *(u32x4*)(d0 + (size_t)j * K) = o; }
    }
}
__device__ __forceinline__ void signal_done(unsigned* p, int wave) { if (wave == 0 && __builtin_amdgcn_mbcnt_hi(~0u, __builtin_amdgcn_mbcnt_lo(~0u, 0u)) == 0u) xb_add(p, 1u); }
__device__ __forceinline__ unsigned convq_take(unsigned* ctl, bool allow2) {
    unsigned it = xb_add(ctl + CW_Q, 1u); if (it < (unsigned)CQ_M13) return it;
    if (allow2) { it = xb_add(ctl + CW_Q + 32, 1u); if (it < (unsigned)CQ_M2) return 0x80000000u | it; }
    return CQ_END;
}
__device__ __forceinline__ void conv_run(const float* m1, const float* m3, const float* m2, bf16* mup, bf16* mdn, unsigned* ctl, volatile LAS unsigned* bc, bool allow2, unsigned* done, unsigned target, int quota, int extra = 0) {
    int tid = threadIdx.x; asm volatile("" : "+v"(tid)); const int lane = tid & 63, wave = __builtin_amdgcn_readfirstlane(tid >> 6);
    unsigned nxt = CQ_END; int left = quota;
    if (tid == 0) { if (done != nullptr && left > extra && xb_ld(done) >= target) left = extra; nxt = left <= 0 ? CQ_END : convq_take(ctl, allow2); --left; }
    int par = 0;
#pragma unroll 1
    for (;;) {
        if (tid == 0) bc[par] = nxt;
        __syncthreads();
        const unsigned cur = __builtin_amdgcn_readfirstlane(bc[par]); par ^= 2;
        if (cur == CQ_END) break;
        if (tid == 0) { if (done != nullptr && left > extra && xb_ld(done) >= target) left = extra; nxt = left <= 0 ? CQ_END : convq_take(ctl, allow2); --left; }
        const int p = (int)(cur & 0x7FFFFFFFu);
        if ((cur >> 31) == 0u) { const int e = p / 448, w3 = (p / 224) & 1, q = p % 224;
            conv_span128((w3 ? m3 : m1) + (size_t)e * D * FFE, FFE, D, mup + (size_t)e * 2 * FFE * D, 2 + w3, q / 7, (q % 7) * 1024 + wave * 128, lane); }
        else { const int e = p / 224, q = p % 224, kb = q >> 1, h = kb / 56;
            conv_span128(m2 + (size_t)e * FFE * D + (size_t)h * (FFE / 2) * D, 2048, FFE / 2, mdn + (size_t)(e * 2 + h) * D * (FFE / 2), 0, kb - 56 * h, (q & 1) * 1024 + wave * 128, lane); }
    }
}
__device__ __forceinline__ float rms_row_load(const float* xrow, int lane, f32x4 (&v)[8]) {
    const f32x4* xr = (const f32x4*)xrow + lane; float s = 0.f;
#pragma unroll
    for (int j = 0; j < 8; ++j) { v[j] = xr[64 * j]; s += (v[j].x * v[j].x + v[j].y * v[j].y) + (v[j].z * v[j].z + v[j].w * v[j].w); }
    return 1.0f / sqrtf(wave_sum(s) * (1.0f / D) + EPS);
}
__device__ __forceinline__ void rms_row_to_bf16(const float* xrow, const float* gain, bf16* orow, int lane) {
    f32x4 v[8]; const float rstd = rms_row_load(xrow, lane, v);
    const f32x4* gr = (const f32x4*)gain + lane; unsigned long long* o8 = (unsigned long long*)orow + lane;
#pragma unroll
    for (int j = 0; j < 8; ++j) { const f32x4 g = gr[64 * j]; o8[64 * j] = (unsigned long long)pk2(v[j].x * rstd * g.x, v[j].y * rstd * g.y) | ((unsigned long long)pk2(v[j].z * rstd * g.z, v[j].w * rstd * g.w) << 32); }
}

namespace nsa {
constexpr int KST = 72;
constexpr int VST2 = 136;
constexpr int L_KS = 0;
constexpr int L_VT = 9216;
constexpr int L_KC = 18432;
constexpr int L_VC = 36864;
constexpr int L_IA = 54272;
constexpr int L_IB = 87040;
constexpr int L_MASK = 119808;
constexpr int L_TL = 120064;
constexpr int L_KS2 = 120576;
constexpr int L_VT2 = 129792;
__device__ __forceinline__ int kperm(int key) { return (key & ~12) | ((key & 4) << 1) | ((key & 8) >> 1); }

__device__ __forceinline__ void unit(LAS unsigned char* lds, const bf16* Z, const bf16* kct, const bf16* vct, bf16* OAp, int b, int g, int iq, const int tid_in) {
    int tid = tid_in; asm volatile("" : "+v"(tid));
    const int lane = tid & 63, r32 = lane & 31, hi = lane >> 5; const int w = __builtin_amdgcn_readfirstlane(tid >> 6);
    const int j = w >> 1, hq = 4 * g + j, tl = 32 * (w & 1) + r32, t0 = 64 * iq, t = t0 + tl;
    const size_t rowZ = (size_t)(b * T + t) * ZLD;
    LAS bf16* KS = (LAS bf16*)(lds + L_KS); LAS bf16* VT = (LAS bf16*)(lds + L_VT); LAS bf16* KC = (LAS bf16*)(lds + L_KC); LAS bf16* VC = (LAS bf16*)(lds + L_VC);
    LAS float* IA = (LAS float*)(lds + L_IA); LAS float* IB = (LAS float*)(lds + L_IB); LAS unsigned* MSK = (LAS unsigned*)(lds + L_MASK); LAS int* TL = (LAS int*)(lds + L_TL);
    bf16x8 qr[4];
#pragma unroll
    for (int d0 = 0; d0 < 4; ++d0) qr[d0] = *(const bf16x8*)(Z + rowZ + ZQ + hq * 64 + 16 * d0 + 8 * hi);
    const float slope2 = __builtin_amdgcn_exp2f(-0.5f * (float)(hq + 1)) * LOG2E;
    float gate[3];
#pragma unroll
    for (int x = 0; x < 3; ++x) gate[x] = sigmoidf_(bf2f(Z[rowZ + ZNG + hq * 3 + x]));
    f32x16 otot[2];
#pragma unroll
    for (int r = 0; r < 16; ++r) { otot[0][r] = 0.f; otot[1][r] = 0.f; }

    {
        const bf16* kc = kct + (size_t)((b * 4 + g) * 128) * 64; const bf16* vc = vct + (size_t)((b * 4 + g) * 128) * 64;
#pragma unroll
        for (int q = 0; q < 2; ++q) { const int idx = tid + 512 * q, key = idx >> 3, ch = idx & 7;
            const v4u kv = *(const v4u*)(kc + key * 64 + ch * 8); *(LAS v4u*)(KC + key * KST + ch * 8) = kv;
            const v4u vv = *(const v4u*)(vc + key * 64 + ch * 8); const int pos = kperm(key);
            const unsigned ww[4] = {vv.x, vv.y, vv.z, vv.w};
#pragma unroll
            for (int e = 0; e < 4; ++e) { VC[(ch * 8 + 2 * e) * VST2 + pos] = (bf16)(ww[e] & 0xffffu); VC[(ch * 8 + 2 * e + 1) * VST2 + pos] = (bf16)(ww[e] >> 16); } }
    }
    __syncthreads();
    {
        f32x16 p[4];
#pragma unroll
        for (int blk = 0; blk < 4; ++blk) {
#pragma unroll
            for (int r = 0; r < 16; ++r) p[blk][r] = 0.f;
#pragma unroll
            for (int d0 = 0; d0 < 4; ++d0) { const bf16x8 kf = *(const LAS bf16x8*)(KC + (32 * blk + r32) * KST + 16 * d0 + 8 * hi); p[blk] = MFMA32(kf, qr[d0], p[blk]); }
        }
        float mx = -INFINITY;
#pragma unroll
        for (int blk = 0; blk < 4; ++blk)
#pragma unroll
            for (int r = 0; r < 16; ++r) { const int c = 32 * blk + crow(r, hi); const int dist = t - (16 * c + 31); const bool ok = (dist >= 0) && (c < 127);
                const float s = ok ? p[blk][r] - slope2 * (float)dist : -INFINITY; p[blk][r] = s; mx = fmaxf(mx, s); }
        mx = fmaxf(mx, __shfl_xor(mx, 32));
        const float msafe = (mx == -INFINITY) ? 0.f : mx;
        float l = 0.f;
#pragma unroll
        for (int blk = 0; blk < 4; ++blk)
#pragma unroll
            for (int r = 0; r < 16; ++r) { const float e = __builtin_amdgcn_exp2f(p[blk][r] - msafe); p[blk][r] = e; l += e; }
        l += __shfl_xor(l, 32);
        const float inv = l > 0.f ? 1.0f / l : 0.f;
#pragma unroll
        for (int blk = 0; blk < 4; ++blk)
#pragma unroll
            for (int r = 0; r < 16; ++r) p[blk][r] *= inv;
#pragma unroll
        for (int blk = 0; blk < 4; ++blk)
#pragma unroll
            for (int rq = 0; rq < 4; ++rq) { const int n = 8 * blk + 2 * rq + hi;
                IA[(j * 64 + tl) * 32 + n] = 2.f * (p[blk][4 * rq] + p[blk][4 * rq + 1] + p[blk][4 * rq + 2]) + p[blk][4 * rq + 3];
                IB[(j * 64 + tl) * 32 + n] = p[blk][4 * rq + 3]; }
        f32x16 oc[2];
#pragma unroll
        for (int r = 0; r < 16; ++r) { oc[0][r] = 0.f; oc[1][r] = 0.f; }
#pragma unroll
        for (int s = 0; s < 8; ++s) { const int blk = s >> 1, rb = 8 * (s & 1);
            u32x4 pw; pw.x = cvt_pk_bf16(p[blk][rb + 0], p[blk][rb + 1]); pw.y = cvt_pk_bf16(p[blk][rb + 2], p[blk][rb + 3]); pw.z = cvt_pk_bf16(p[blk][rb + 4], p[blk][rb + 5]); pw.w = cvt_pk_bf16(p[blk][rb + 6], p[blk][rb + 7]);
            const bf16x8 pa = __builtin_bit_cast(bf16x8, pw);
#pragma unroll
            for (int db = 0; db < 2; ++db) { const bf16x8 vf = *(const LAS bf16x8*)(VC + (32 * db + r32) * VST2 + 16 * s + 8 * hi); oc[db] = MFMA32(vf, pa, oc[db]); } }
#pragma unroll
        for (int r = 0; r < 16; ++r) { otot[0][r] += gate[0] * oc[0][r]; otot[1][r] += gate[0] * oc[1][r]; }
    }
    __syncthreads();
    {
        const int n = lane & 31;
#pragma unroll
        for (int q = 0; q < 4; ++q) { const int tk = (tid >> 5) + 16 * q;
            float imp = 0.f;
#pragma unroll
            for (int jj = 0; jj < 4; ++jj) { imp += IA[(jj * 64 + tk) * 32 + n]; if (n > 0) imp += IB[(jj * 64 + tk) * 32 + n - 1]; }
            const bool valid = n <= iq, forced = (n == 0) || (n == iq) || (n == iq - 1);
            const float sc = forced ? 1e4f : (valid ? imp : -1.0f);
            int cnt = 0;
#pragma unroll
            for (int mm = 0; mm < 32; ++mm) { const float so = __shfl(sc, (lane & 32) + mm); cnt += (so > sc || (so == sc && mm < n)) ? 1 : 0; }
            const unsigned long long bal = __ballot(cnt < 16);
            if (n == 0) MSK[tk] = (unsigned)((lane & 32) ? (bal >> 32) : bal); }
    }
    __syncthreads();
    const unsigned mymask = MSK[tl];
    if (tid < 64) {
        unsigned un = MSK[lane];
#pragma unroll
        for (int o = 1; o < 64; o <<= 1) un |= __shfl_xor(un, o);
        if (lane == 0) { int cnt = 0;
            for (int n = iq; n >= 0; --n) if ((un >> n) & 1u) TL[1 + cnt++] = n | 0x100;
            for (int n = iq; n >= (iq >= 8 ? iq - 8 : 0); --n) TL[1 + cnt++] = n | 0x200;
            TL[0] = cnt; }
    }
    __syncthreads();
    {
        const int ntile = TL[0];
        const int skey = tid >> 3, sch = tid & 7;
        const int vkp = tid & 31, vc4 = tid >> 5, vpos = kperm(2 * vkp);
        LAS bf16* KSb[2] = {KS, KC}; LAS bf16* VTb[2] = {VT, VC};
        v4u kreg, vreg;
#define NSA_LOAD(ee) do { const int n_ = (ee) & 0xff, br_ = (ee) >> 8; const size_t ro_ = (size_t)(b * T + 64 * n_ + skey) * ZLD + g * 64 + sch * 8; \
            kreg = *(const v4u*)(Z + ro_ + (br_ == 1 ? ZKS : ZKW)); \
            const size_t rv_ = (size_t)(b * T + 64 * n_ + 2 * vkp) * ZLD + g * 64 + 4 * vc4 + (br_ == 1 ? ZVS : ZVW); \
            const v2u va_ = *(const v2u*)(Z + rv_), vb_ = *(const v2u*)(Z + rv_ + ZLD); vreg = (v4u){va_.x, va_.y, vb_.x, vb_.y}; } while (0)
#define NSA_STORE(bi) do { *(LAS v4u*)(KSb[bi] + skey * KST + sch * 8) = kreg; \
              \
            LAS unsigned* vt_ = (LAS unsigned*)(VTb[bi] + (4 * vc4) * KST + vpos); \
            vt_[0 * (KST / 2)] = (vreg.x & 0xffffu) | (vreg.z << 16); vt_[1 * (KST / 2)] = (vreg.x >> 16) | (vreg.z & 0xffff0000u); \
            vt_[2 * (KST / 2)] = (vreg.y & 0xffffu) | (vreg.w << 16); vt_[3 * (KST / 2)] = (vreg.y >> 16) | (vreg.w & 0xffff0000u); } while (0)
        NSA_LOAD(TL[1]); NSA_STORE(0);
        if (ntile > 1) NSA_LOAD(TL[2]);
        asm volatile("s_waitcnt lgkmcnt(0)\n\ts_barrier" ::: "memory");
        float mref = 0.f, l_run = 0.f; f32x16 o[2];
#pragma unroll
        for (int r = 0; r < 16; ++r) { o[0][r] = 0.f; o[1][r] = 0.f; }
        int curbr = TL[1] >> 8; bool first = true;
        for (int k = 0; k < ntile; ++k) {
            const int e = TL[1 + k], n = e & 0xff, br = e >> 8, bi = k & 1;
            if (br != curbr) {
                l_run += __shfl_xor(l_run, 32);
                const float sc = gate[1] / l_run;
#pragma unroll
                for (int r = 0; r < 16; ++r) { otot[0][r] += sc * o[0][r]; otot[1][r] += sc * o[1][r]; o[0][r] = 0.f; o[1][r] = 0.f; }
                mref = 0.f; l_run = 0.f; curbr = br; first = true;
            }
            const bool sel = (br == 1) ? (((mymask >> n) & 1u) != 0u) : true;
            const float base = sel ? (slope2 * (float)(64 * n + 4 * hi - t) - mref) : -INFINITY;
            f32x16 p0, p1;
            if (n == iq) {
#pragma unroll
                for (int r = 0; r < 16; ++r) { const float cr = (float)((r & 3) + 8 * (r >> 2)); const int c = crow(r, hi);
                    p0[r] = (c > tl) ? -INFINITY : fmaf(slope2, cr, base); p1[r] = (c + 32 > tl) ? -INFINITY : fmaf(slope2, cr + 32.f, base); }
            } else if (br == 2 && n == iq - 8) {
#pragma unroll
                for (int r = 0; r < 16; ++r) { const float cr = (float)((r & 3) + 8 * (r >> 2)); const int c = crow(r, hi);
                    p0[r] = (c <= tl) ? -INFINITY : fmaf(slope2, cr, base); p1[r] = (c + 32 <= tl) ? -INFINITY : fmaf(slope2, cr + 32.f, base); }
            } else {
#pragma unroll
                for (int r = 0; r < 16; ++r) { const float cr = (float)((r & 3) + 8 * (r >> 2)); p0[r] = fmaf(slope2, cr, base); p1[r] = fmaf(slope2, cr + 32.f, base); }
            }
#pragma unroll
            for (int d0 = 0; d0 < 4; ++d0) {
                const bf16x8 k0 = *(const LAS bf16x8*)(KSb[bi] + r32 * KST + 16 * d0 + 8 * hi);
                const bf16x8 k1 = *(const LAS bf16x8*)(KSb[bi] + (r32 + 32) * KST + 16 * d0 + 8 * hi);
                p0 = MFMA32(k0, qr[d0], p0); p1 = MFMA32(k1, qr[d0], p1); }
            float mx = fmaxf(p0[0], p1[0]);
#pragma unroll
            for (int r = 1; r < 16; ++r) mx = fmaxf(mx, fmaxf(p0[r], p1[r]));
            mx = fmaxf(mx, __shfl_xor(mx, 32));
            if (first) {
                const float dl = (mx == -INFINITY) ? 0.f : mx; mref += dl;
#pragma unroll
                for (int r = 0; r < 16; ++r) { p0[r] -= dl; p1[r] -= dl; }
                first = false;
            } else if (__any(mx > 8.0f)) {
                const float dl = fmaxf(mx, 0.f); mref += dl;
                const float f = __builtin_amdgcn_exp2f(-dl); l_run *= f;
#pragma unroll
                for (int r = 0; r < 16; ++r) { p0[r] -= dl; p1[r] -= dl; o[0][r] *= f; o[1][r] *= f; }
            }
            float rs = 0.f;
#pragma unroll
            for (int r = 0; r < 16; ++r) { p0[r] = __builtin_amdgcn_exp2f(p0[r]); p1[r] = __builtin_amdgcn_exp2f(p1[r]); rs += p0[r] + p1[r]; }
            l_run += rs;
#pragma unroll
            for (int s = 0; s < 4; ++s) {
                u32x4 pw;
                if (s < 2) { const int rb = 8 * s; pw.x = cvt_pk_bf16(p0[rb + 0], p0[rb + 1]); pw.y = cvt_pk_bf16(p0[rb + 2], p0[rb + 3]); pw.z = cvt_pk_bf16(p0[rb + 4], p0[rb + 5]); pw.w = cvt_pk_bf16(p0[rb + 6], p0[rb + 7]); }
                else { const int rb = 8 * (s - 2); pw.x = cvt_pk_bf16(p1[rb + 0], p1[rb + 1]); pw.y = cvt_pk_bf16(p1[rb + 2], p1[rb + 3]); pw.z = cvt_pk_bf16(p1[rb + 4], p1[rb + 5]); pw.w = cvt_pk_bf16(p1[rb + 6], p1[rb + 7]); }
                const bf16x8 pa = __builtin_bit_cast(bf16x8, pw);
#pragma unroll
                for (int db = 0; db < 2; ++db) { const bf16x8 vf = *(const LAS bf16x8*)(VTb[bi] + (32 * db + r32) * KST + 16 * s + 8 * hi); o[db] = MFMA32(vf, pa, o[db]); } }
            if (k + 1 < ntile) { NSA_STORE(bi ^ 1); if (k + 2 < ntile) NSA_LOAD(TL[3 + k]); }
            asm volatile("s_waitcnt lgkmcnt(0)\n\ts_barrier" ::: "memory");
        }
        { l_run += __shfl_xor(l_run, 32); const float sc = gate[2] / l_run;
#pragma unroll
          for (int r = 0; r < 16; ++r) { otot[0][r] += sc * o[0][r]; otot[1][r] += sc * o[1][r]; } }
#undef NSA_LOAD
#undef NSA_STORE
    }
    {
        bf16* orow = OAp + (size_t)(b * T + t) * 1024 + hq * 64;
#pragma unroll
        for (int db = 0; db < 2; ++db)
#pragma unroll
            for (int rq = 0; rq < 4; ++rq) { v2u wv; wv.x = cvt_pk_bf16(otot[db][4 * rq], otot[db][4 * rq + 1]); wv.y = cvt_pk_bf16(otot[db][4 * rq + 2], otot[db][4 * rq + 3]);
                *(v2u*)(orow + 32 * db + 8 * rq + 4 * hi) = wv; }
    }
    __syncthreads();
}
}

namespace sgu {
constexpr int ST = 136;
constexpr int L_W = 0;
constexpr int L_V = 34816;
constexpr int L_U = 69632;
constexpr int L_STAT = 104448;
constexpr int L_B = 105472;
__device__ __forceinline__ void unit(LAS unsigned char* lds, const bf16* Z, const bf16* sgw, const float* lng, const float* lnb, const float* sgb, bf16* OBp, int b, int nchunk, int g0, int ng, const int tid_in) {
    int tid = tid_in; asm volatile("" : "+v"(tid));
    const int lane = tid & 63, r32 = lane & 31, hi = lane >> 5; const int w = __builtin_amdgcn_readfirstlane(tid >> 6);
    LAS bf16* WL = (LAS bf16*)(lds + L_W); LAS bf16* VL = (LAS bf16*)(lds + L_V); LAS bf16* UL = (LAS bf16*)(lds + L_U); LAS float* STAT = (LAS float*)(lds + L_STAT); LAS float* BL = (LAS float*)(lds + L_B);
    const int tb0 = b * T + 128 * nchunk;
    for (int k = 0; k < 16; ++k) { const int tok = 16 * w + k; const bf16* row = Z + (size_t)(tb0 + tok) * ZLD + ZV;
        float s = 0.f, ss = 0.f;
#pragma unroll
        for (int q = 0; q < 2; ++q) { const v4u vv = *(const v4u*)(row + q * 512 + lane * 8); const unsigned ww[4] = {vv.x, vv.y, vv.z, vv.w};
#pragma unroll
            for (int e = 0; e < 4; ++e) { const float a = bflo(ww[e]), c = bfhi(ww[e]); s += a + c; ss += a * a + c * c; } }
        s = wave_sum(s); ss = wave_sum(ss);
        const float mean = s * (1.0f / 1024.0f); const float var = fmaxf(ss * (1.0f / 1024.0f) - mean * mean, 0.f);
        if (lane == 0) { STAT[tok * 2] = mean; STAT[tok * 2 + 1] = 1.0f / sqrtf(var + EPS); } }
    __syncthreads();
#pragma unroll 1
    for (int g = g0; g < g0 + ng; ++g) {
        if (tid < 128) BL[tid] = sgb[g * 128 + tid];
#pragma unroll
        for (int q = 0; q < 4; ++q) { const int idx = tid + 512 * q, row = idx >> 4, ch = idx & 15;
            *(LAS v4u*)(WL + row * ST + ch * 8) = *(const v4u*)(sgw + (size_t)(g * 128 + row) * 128 + ch * 8);
            *(LAS v4u*)(UL + row * ST + ch * 8) = *(const v4u*)(Z + (size_t)(tb0 + row) * ZLD + ZU + g * 128 + ch * 8);
            const v4u vv = *(const v4u*)(Z + (size_t)(tb0 + row) * ZLD + ZV + g * 128 + ch * 8); const unsigned ww[4] = {vv.x, vv.y, vv.z, vv.w};
            const float mean = STAT[row * 2], rstd = STAT[row * 2 + 1];
#pragma unroll
            for (int e = 0; e < 4; ++e) { const int c0 = g * 128 + ch * 8 + 2 * e;
                const float a = (bflo(ww[e]) - mean) * rstd * lng[c0] + lnb[c0], c = (bfhi(ww[e]) - mean) * rstd * lng[c0 + 1] + lnb[c0 + 1];
                VL[(ch * 8 + 2 * e) * ST + row] = (bf16)f2bf(a); VL[(ch * 8 + 2 * e + 1) * ST + row] = (bf16)f2bf(c); } }
        __syncthreads();
        const int tb = w >> 1, dbase = (w & 1) * 2;
        f32x16 acc[2];
#pragma unroll
        for (int r = 0; r < 16; ++r) { acc[0][r] = 0.f; acc[1][r] = 0.f; }
        for (int ks = 0; ks < 2 * (tb + 1); ++ks) {
            const bf16x8 a = *(const LAS bf16x8*)(WL + (32 * tb + r32) * ST + 16 * ks + 8 * hi);
#pragma unroll
            for (int x = 0; x < 2; ++x) { const bf16x8 bb = *(const LAS bf16x8*)(VL + (32 * (dbase + x) + r32) * ST + 16 * ks + 8 * hi); acc[x] = MFMA32(a, bb, acc[x]); } }
#pragma unroll
        for (int x = 0; x < 2; ++x)
#pragma unroll
            for (int r = 0; r < 16; ++r) { const int tt = 32 * tb + crow(r, hi); LAS bf16* up = UL + tt * ST + 32 * (dbase + x) + r32;
                *up = (bf16)f2bf(bf2f(*up) * (acc[x][r] + BL[tt])); }
        __syncthreads();
#pragma unroll
        for (int q = 0; q < 4; ++q) { const int idx = tid + 512 * q, row = idx >> 4, ch = idx & 15;
            *(v4u*)(OBp + (size_t)(tb0 + row) * 1024 + g * 128 + ch * 8) = *(const LAS v4u*)(UL + row * ST + ch * 8); }
        __syncthreads();
    }
}
}

#define WIN_T ((bf16*)(ws + WS_WIN))
#define CW1_T ((bf16*)(ws + WS_CW1))
#define CW2_T ((bf16*)(ws + WS_CW2))
#define CB1 ((float*)(ws + WS_CB1))
#define WA_T ((bf16*)(ws + WS_WA))
#define WB_T ((bf16*)(ws + WS_WB))
#define WO_T ((bf16*)(ws + WS_WO))
#define SGW ((bf16*)(ws + WS_SGW))
#define FUP_T ((bf16*)(ws + WS_FUP))
#define FDN_T ((bf16*)(ws + WS_FDN))
#define MUP_T ((bf16*)(ws + WS_MUP))
#define MDN_T ((bf16*)(ws + WS_MDN))
#define Hb ((bf16*)(ws + WS_H))
#define XA ((float*)(ws + WS_XA))
#define HPERM ((bf16*)(ws + WS_HPERM))
#define YPERM ((bf16*)(ws + WS_YPERM))
#define KCT ((bf16*)(ws + WS_KCT))
#define HID ((bf16*)(ws + WS_HID))
#define Zb ((bf16*)(ws + WS_Z))
#define FLAT ((bf16*)(ws + WS_FLAT))
#define OA ((bf16*)(ws + WS_OA))
#define OB ((bf16*)(ws + WS_OB))
#define TMP ((bf16_t*)(ws + WS_TMP))
#define Yb ((bf16*)(ws + WS_Y))
#define GBUF ((bf16*)(ws + WS_GBUF))
#define TOKE ((int*)(ws + WS_ROUTE + RT_TOKE))
#define TOKW ((float*)(ws + WS_ROUTE + RT_TOKW))
#define TOKP ((int*)(ws + WS_ROUTE + RT_TOKP))
#define RGATE ((float*)(ws + WS_ROUTE + RT_RGATE))
#define CNT ((int*)(ws + WS_ROUTE + RT_CNT))
#define TILEE ((int*)(ws + WS_ROUTE + RT_TILEE))
__global__ void __launch_bounds__(NWAVES * 64, 2) trunk_fwd(Args args) {
    extern __shared__ __attribute__((aligned(16))) unsigned char lds_raw[];
    LAS unsigned char* lds = (LAS unsigned char*)lds_raw;
    volatile LAS unsigned* MISC = (volatile LAS unsigned*)(lds + LDS_MISC);
    const int tid = threadIdx.x, lane = tid & 63; const int wave = __builtin_amdgcn_readfirstlane(tid >> 6);
    const int G = gridDim.x, bx = blockIdx.x;
    unsigned char* ws = args.ws;
    unsigned* ctl = (unsigned*)(ws + WS_CTL);
    for (int u = tid; u < (LDS_BYTES - LDS_MISC) / 4; u += NWAVES * 64) ((LAS unsigned*)(lds + LDS_MISC))[u] = 0u;
    __syncthreads();
    const int lo = args.ph_lo, hi = args.ph_hi;
    XcdBarrier bar; bar.bar = ctl + CW_BAR; bar.x = 0; bar.st = nullptr;
    if (hi - lo > 1) bar = xcd_barrier_post(ctl + CW_BAR, MISC + 8);
#ifndef PH_MASK
#define PH_MASK 0xFFFFFFFFu
#endif
#define EN(i) (((PH_MASK) >> (i)) & 1u)
#define IN(k) (lo <= (k) && (k) < hi)
#define SEAM(k) do { if (IN(k) && IN((k) + 1)) xcd_barrier(bar); } while (0)

    const int gw = bx * NWAVES + wave, ngw = G * NWAVES;

    if (EN(0) && IN(0)) {
        LAS float* scr = (LAS float*)(lds + wave * 16384);
        if (wave < 4 && bx >= G - 32 && G >= 32) { const int tk = (bx - (G - 32)) * 4 + wave, l = tk >> 6, kv = (tk >> 5) & 1, n = (tk & 31) * 8 + (lane & 7), k8 = lane >> 3;
            const float* pe = args.in[kv ? I_PEV : I_PEK] + (size_t)l * 2048; const float* w1 = args.in[kv ? I_VW1 : I_KW1] + (size_t)l * 2048 * 256;
            float sacc = 0.f;
#pragma unroll 16
            for (int k = k8; k < 2048; k += 8) sacc += pe[k] * w1[(size_t)k * 256 + n];
            sacc += __shfl_xor(sacc, 8); sacc += __shfl_xor(sacc, 16); sacc += __shfl_xor(sacc, 32);
            if (k8 == 0) CB1[(l * 2 + kv) * 256 + n] = sacc; }
        {
            constexpr int C_WIN = 2 * 32 * 35, C_WAB = 2 * 2 * 16 * 8, C_WO = 2 * 32 * 8, C_CW1 = 4 * 32, C_CW2 = 4 * 4, C_F13 = 2 * 32 * 22, C_F2 = 88 * 8, C_M13 = 8 * 2 * 32 * 28, C_M2 = 8 * 112 * 8;
            constexpr int C_TOT = C_WIN + C_WAB + C_WO + C_CW1 + C_CW2 + C_F13 + C_F2;
            for (int it = bx; it < C_TOT; it += G) {
                int r = it;
                if (r < C_WIN) { const int l = r / (32 * 35), q = r % (32 * 35); conv_tile(args.in[I_WIN] + (size_t)l * D * IN_W, IN_W, D, IN_W, WIN_T + (size_t)l * ZLD * D, 1, q / 35, q % 35, lane, wave, wave + 1); continue; } r -= C_WIN;
                if (r < C_WAB) { const int ab = r / (2 * 16 * 8), l = (r / (16 * 8)) & 1, q = r % (16 * 8); conv_tile(args.in[ab ? I_WB : I_WA] + (size_t)l * 1024 * 2048, 2048, 1024, 2048, (ab ? WB_T : WA_T) + (size_t)l * 2048 * 1024, 0, q / 8, q % 8, lane, wave, wave + 1); continue; } r -= C_WAB;
                if (r < C_WO) { const int l = r / (32 * 8), q = r % (32 * 8); conv_tile(args.in[I_WO] + (size_t)l * 2048 * 2048, 2048, 2048, 2048, WO_T + (size_t)l * 2048 * 2048, 0, q / 8, q % 8, lane, wave, wave + 1); continue; } r -= C_WO;
                if (r < C_CW1) { const int lk = r / 32, q = r % 32; conv_tile(args.in[(lk & 1) ? I_VW1 : I_KW1] + (size_t)(lk >> 1) * 2048 * 256, 256, 2048, 256, CW1_T + (size_t)lk * 256 * 2048, 0, q, 0, lane, wave, wave + 1); continue; } r -= C_CW1;
                if (r < C_CW2) { const int lk = r / 4, q = r % 4; conv_tile(args.in[(lk & 1) ? I_VW2 : I_KW2] + (size_t)(lk >> 1) * 256 * 64, 64, 256, 64, CW2_T + (size_t)lk * 64 * 256, 0, q, 0, lane, wave, wave + 1); continue; } r -= C_CW2;
                if (r < C_F13) { const int w3 = r / (32 * 22), q = r % (32 * 22); conv_tile(args.in[w3 ? I_F3 : I_F1], FFD, D, FFD, FUP_T, 2 + w3, q / 22, q % 22, lane, wave, wave + 1); continue; } r -= C_F13;
                { conv_tile(args.in[I_F2], 2048, FFD, 2048, FDN_T, 0, r / 8, r % 8, lane, wave, wave + 1); }
            }
            for (int i = bx * 512 + tid; i < 2 * 208 * 256; i += G * 512) { const int l = i / (208 * 256), q = i % (208 * 256); *(u32x4*)(WIN_T + (size_t)l * ZLD * D + (size_t)(2608 + q / 256) * D + (q % 256) * 8) = (u32x4){0u, 0u, 0u, 0u}; }
        }
        for (int idx = bx * 512 + tid; idx < 2 * 8 * 128 * 128; idx += G * 512) { const int tt = (idx >> 7) & 127, s = idx & 127; SGW[idx] = (bf16)f2bf(s <= tt ? args.in[I_SGW][idx] : 0.f); }
        for (int m = gw; m < M; m += ngw) rms_row_to_bf16(args.in[I_X] + (size_t)m * D, args.in[I_NMIX], Hb + (size_t)m * D, lane);
    }
    SEAM(0);

    for (int layer = 0; layer < 2; ++layer) {
        const int pb = 1 + layer * 11;
        const float* xin = layer == 0 ? args.in[I_X] : XA;
        if (EN(1) && IN(pb + 0)) {
            int tz = threadIdx.x; asm volatile("" : "+v"(tz)); const int lane = tz & 63; const int wave = __builtin_amdgcn_readfirstlane(tz >> 6); const int tid = tz; const int gw = bx * NWAVES + wave; (void)lane; (void)tid; (void)gw;
            const int gg = (G == 256) ? 224 : G;
            if (bx < gg) {
                pg8::Gemm g{Hb, WIN_T + (size_t)layer * ZLD * D, M, ZLD, D, 0}; pg8::StaticOrder S; S.init(M, ZLD, gg, bx);
                pg8::EpiWin E{Zb, FLAT};
                pg8::gemm_phase(lds, g, S, E, tz, ctl + CW_DONE(layer * 3 + 0));
            } else conv_run(args.in[I_M1], args.in[I_M3], args.in[I_M2], MUP_T, MDN_T, ctl, MISC + 16, true, ctl + CW_DONE(layer * 3 + 0), 16u, 1 << 30, 1);
        }
        SEAM(pb + 0);
        if (EN(2) && IN(pb + 1)) {
            int tz = threadIdx.x; asm volatile("" : "+v"(tz)); const int lane = tz & 63; const int wave = __builtin_amdgcn_readfirstlane(tz >> 6); const int tid = tz; const int gw = bx * NWAVES + wave; (void)lane; (void)tid; (void)gw;
            if (bx < 16) {
                pg8::Gemm g{FLAT, CW1_T + (size_t)layer * 2 * 256 * 2048, 4096, 256, 2048, (size_t)256 * 2048 * 2}; pg8::CmpOrder S{bx};
                pg8::EpiCmp E{HID, CB1 + layer * 512};
                pg8::gemm_phase(lds, g, S, E, tz);
                __builtin_amdgcn_fence(__ATOMIC_RELEASE, "workgroup"); __syncthreads(); __builtin_amdgcn_fence(__ATOMIC_ACQUIRE, "workgroup");
                const int wt = bx * NWAVES + wave;
                if (wt < 128) { const int kv = wt >> 6, rb = wt & 63, r32 = lane & 31, hh = lane >> 5;
                    const bf16* A = HID + (size_t)(kv * 2048 + 32 * rb + r32) * 256; const bf16* W2 = CW2_T + (size_t)(layer * 2 + kv) * 64 * 256;
                    f32x16 acc[2];
    #pragma unroll
                    for (int r = 0; r < 16; ++r) { acc[0][r] = 0.f; acc[1][r] = 0.f; }
    #pragma unroll 8
                    for (int ks = 0; ks < 16; ++ks) { const bf16x8 a = *(const bf16x8*)(A + 16 * ks + 8 * hh);
    #pragma unroll
                        for (int nb = 0; nb < 2; ++nb) { const bf16x8 bb = *(const bf16x8*)(W2 + (size_t)(32 * nb + r32) * 256 + 16 * ks + 8 * hh); acc[nb] = MFMA32(a, bb, acc[nb]); } }
    #pragma unroll
                    for (int nb = 0; nb < 2; ++nb)
    #pragma unroll
                        for (int r = 0; r < 16; ++r) { const int rho = 32 * rb + crow(r, hh), b = rho >> 9, c = (rho >> 2) & 127, gg = rho & 3;
                            KCT[(size_t)kv * 16 * 128 * 64 + (size_t)((b * 4 + gg) * 128 + c) * 64 + 32 * nb + r32] = (bf16)f2bf(acc[nb][r]); } }
            } else if (bx < 144 || G < 160) {
                for (int u = bx - 16; u < 128; u += (G < 160 ? G : 144) - 16)
                    sgu::unit(lds, Zb, SGW + (size_t)layer * 8 * 128 * 128, args.in[I_LNG] + layer * 1024, args.in[I_LNB] + layer * 1024, args.in[I_SGB] + layer * 1024, OB, u >> 5, (u >> 1) & 15, (u & 1) * 4, 4, tz);
                __syncthreads();
                conv_run(args.in[I_M1], args.in[I_M3], args.in[I_M2], MUP_T, MDN_T, ctl, MISC + 16, true, nullptr, 0u, 1);
            } else conv_run(args.in[I_M1], args.in[I_M3], args.in[I_M2], MUP_T, MDN_T, ctl, MISC + 16, true, nullptr, 0u, 4);
        }
        SEAM(pb + 1);
        if (EN(4) && IN(pb + 3)) {
            int tz = threadIdx.x; asm volatile("" : "+v"(tz)); const int lane = tz & 63; const int wave = __builtin_amdgcn_readfirstlane(tz >> 6); const int tid = tz; const int gw = bx * NWAVES + wave; (void)lane; (void)tid; (void)gw;
            for (int L = bx; L < 512; L += G) { int bg, iq; if (L < 256) { bg = L >> 4; iq = 31 - (L & 15); } else { bg = (L - 256) >> 4; iq = (L - 256) & 15; }
                nsa::unit(lds, Zb, KCT, KCT + (size_t)16 * 128 * 64, OA, bg >> 2, bg & 3, iq, tz); }
            __syncthreads();
            signal_done(ctl + CW_DONE(6 + layer), wave);
            if (G == 256) conv_run(args.in[I_M1], args.in[I_M3], args.in[I_M2], MUP_T, MDN_T, ctl, MISC + 16, true, ctl + CW_DONE(6 + layer), 128u, 1 << 30);
        }
        SEAM(pb + 3);
        if (EN(5) && IN(pb + 4)) {
            int tz = threadIdx.x; asm volatile("" : "+v"(tz)); const int lane = tz & 63; const int wave = __builtin_amdgcn_readfirstlane(tz >> 6); const int tid = tz; const int gw = bx * NWAVES + wave; (void)lane; (void)tid; (void)gw;
            pg8::EpiGate E{Zb, TMP, Yb};
            { pg8::Gemm g{OA, WA_T + (size_t)layer * 2048 * 1024, M, D, 1024, 0}; pg8::StaticOrder S; S.init(M, D, G, bx, 0); pg8::gemm_phase(lds, g, S, E, tz); }
            { pg8::Gemm g{OB, WB_T + (size_t)layer * 2048 * 1024, M, D, 1024, 0}; pg8::StaticOrder S; S.init(M, D, G, bx, 1); pg8::gemm_phase(lds, g, S, E, tz); }
        }
        SEAM(pb + 4);
        if (EN(6) && IN(pb + 5)) {
            int tz = threadIdx.x; asm volatile("" : "+v"(tz)); const int lane = tz & 63; const int wave = __builtin_amdgcn_readfirstlane(tz >> 6); const int tid = tz; const int gw = bx * NWAVES + wave; (void)lane; (void)tid; (void)gw;
            pg8::Gemm g{Yb, WO_T + (size_t)layer * 2048 * 2048, M, D, D, 0}; pg8::StaticOrder S; S.init(M, D, G, bx);
            pg8::EpiResid E{xin, XA};
            pg8::gemm_phase(lds, g, S, E, tz);
        }
        SEAM(pb + 5);
        if (EN(7) && IN(pb + 6)) {
            int tz = threadIdx.x; asm volatile("" : "+v"(tz)); const int lane = tz & 63; const int wave = __builtin_amdgcn_readfirstlane(tz >> 6); const int tid = tz; const int gw = bx * NWAVES + wave; (void)lane; (void)tid; (void)gw;
            const float* gain = args.in[I_NFFN] + layer * D;
            if (layer == 0) { for (int m = gw; m < M; m += ngw) rms_row_to_bf16(XA + (size_t)m * D, gain, Hb + (size_t)m * D, lane); }
            else {
                LAS float* RW = (LAS float*)lds;
                LAS int* LC = (LAS int*)(lds + 65536);
                for (int i = tid; i < 2048 * 8; i += 512) RW[i] = args.in[I_RW][i];
                if (tid < 8) LC[tid] = 0;
                __syncthreads();
                const int rpb = (M + G - 1) / G, r0 = bx * rpb, r1 = (r0 + rpb) < M ? (r0 + rpb) : M;
                for (int m = r0 + wave; m < r1; m += NWAVES) {
                    f32x4 v[8]; const float rstd = rms_row_load(XA + (size_t)m * D, lane, v);
                    const f32x4* gr = (const f32x4*)gain + lane; unsigned long long* o8 = (unsigned long long*)(Hb + (size_t)m * D) + lane;
                    float lg[8];
#pragma unroll
                    for (int e = 0; e < 8; ++e) lg[e] = 0.f;
#pragma unroll
                    for (int jj = 0; jj < 8; ++jj) { const f32x4 gg = gr[64 * jj]; const float a0 = v[jj].x * rstd * gg.x, a1 = v[jj].y * rstd * gg.y, a2 = v[jj].z * rstd * gg.z, a3 = v[jj].w * rstd * gg.w;
                        o8[64 * jj] = (unsigned long long)pk2(a0, a1) | ((unsigned long long)pk2(a2, a3) << 32);
                        const int c0 = 256 * jj + 4 * lane; const float av[4] = {a0, a1, a2, a3};
#pragma unroll
                        for (int q = 0; q < 4; ++q) { const f32x4 w0 = *(const LAS f32x4*)(RW + (c0 + q) * 8), w1 = *(const LAS f32x4*)(RW + (c0 + q) * 8 + 4);
                            lg[0] += av[q] * w0.x; lg[1] += av[q] * w0.y; lg[2] += av[q] * w0.z; lg[3] += av[q] * w0.w; lg[4] += av[q] * w1.x; lg[5] += av[q] * w1.y; lg[6] += av[q] * w1.z; lg[7] += av[q] * w1.w; } }
#pragma unroll
                    for (int e = 0; e < 8; ++e) lg[e] = wave_sum(lg[e]) + args.in[I_RB][e];
                    if (lane == 0) { int e0 = 0; float v0 = lg[0];
#pragma unroll
                        for (int e = 1; e < 8; ++e) if (lg[e] > v0) { v0 = lg[e]; e0 = e; }
                        int e1 = -1; float v1 = -INFINITY;
#pragma unroll
                        for (int e = 0; e < 8; ++e) if (e != e0 && lg[e] > v1) { v1 = lg[e]; e1 = e; }
                        const float w0 = 1.0f / (1.0f + expf(v1 - v0));
                        TOKE[2 * m] = e0; TOKE[2 * m + 1] = e1; TOKW[2 * m] = w0; TOKW[2 * m + 1] = 1.0f - w0;
                        atomicAdd((int*)&LC[e0], 1); atomicAdd((int*)&LC[e1], 1); }
                }
                __syncthreads();
                if (tid < 8) CNT[bx * 32 + tid] = LC[tid];
            }
        }
        SEAM(pb + 6);
        if (EN(8) && IN(pb + 7) && layer == 1) {
            int tz = threadIdx.x; asm volatile("" : "+v"(tz)); const int lane = tz & 63; const int wave = __builtin_amdgcn_readfirstlane(tz >> 6); const int tid = tz; const int gw = bx * NWAVES + wave; (void)lane; (void)tid; (void)gw;
            LAS int* SH = (LAS int*)lds;
            const int rpb = (M + G - 1) / G, r0 = bx * rpb, r1 = (r0 + rpb) < M ? (r0 + rpb) : M, npair = 2 * (r1 - r0);
            if (tid < 64) SH[tid] = 0;
            __syncthreads();
            for (int base = 0; base < G; base += 512) {
                const int bb = base + tid;
#pragma unroll
                for (int e = 0; e < 8; ++e) { const int c = bb < G ? CNT[bb * 32 + e] : 0; const float tot = wave_sum((float)c), bef = wave_sum(bb < bx ? (float)c : 0.f);
                    if (lane == 0) { atomicAdd((int*)&SH[e], (int)tot); atomicAdd((int*)&SH[8 + e], (int)bef); } } }
            for (int q = tid; q < npair; q += 512) SH[64 + q] = TOKE[2 * r0 + q];
            __syncthreads();
            if (tid == 0) { int acc = 0;
#pragma unroll 1
                for (int e = 0; e < 8; ++e) { SH[16 + e] = acc; const int nt = (SH[e] + 255) >> 8; if (bx == 0) for (int q = 0; q < nt; ++q) TILEE[acc + q] = e; acc += nt; } SH[24] = acc; if (bx == 0) TILEE[127] = acc;
                if (npair > 64) for (int q = 0; q < npair; ++q) { const int e = SH[64 + q]; SH[320 + q] = SH[16 + e] * 256 + SH[8 + e] + SH[32 + e]; SH[32 + e] += 1; } }
            __syncthreads();
            if (npair <= 64 && tid < 64) {
                const int e = tid < npair ? SH[64 + tid] : -1; int rank = 0;
#pragma unroll
                for (int x = 0; x < 8; ++x) { const unsigned long long mk = __ballot(e == x); if (e == x) rank = __builtin_popcountll(mk & ((1ull << tid) - 1ull)); }
                if (tid < npair) SH[320 + tid] = SH[16 + e] * 256 + SH[8 + e] + rank; }
            __syncthreads();
            for (int q = tid; q < npair; q += 512) { const int pos = SH[320 + q]; TOKP[2 * r0 + q] = pos; }
            for (int q = 2 * wave; q < npair; q += 2 * NWAVES) { const int m = r0 + (q >> 1);
                const v4u* src = (const v4u*)(Hb + (size_t)m * D); v4u* d0 = (v4u*)(HPERM + (size_t)SH[320 + q] * D); v4u* d1 = (v4u*)(HPERM + (size_t)SH[320 + q + 1] * D);
                v4u t[4];
#pragma unroll
                for (int jj = 0; jj < 4; ++jj) t[jj] = src[lane + 64 * jj];
#pragma unroll
                for (int jj = 0; jj < 4; ++jj) { d0[lane + 64 * jj] = t[jj]; d1[lane + 64 * jj] = t[jj]; } }
            __syncthreads();
            conv_run(args.in[I_M1], args.in[I_M3], args.in[I_M2], MUP_T, MDN_T, ctl, MISC + 16, false, nullptr, 0u, 1 << 30);
        }
        if (layer == 1) SEAM(pb + 7);
        if (EN(9) && IN(pb + 8)) {
            int tz = threadIdx.x; asm volatile("" : "+v"(tz)); const int lane = tz & 63; const int wave = __builtin_amdgcn_readfirstlane(tz >> 6); const int tid = tz; const int gw = bx * NWAVES + wave; (void)lane; (void)tid; (void)gw;
            if (layer == 0) { const int gg = (G == 256) ? 235 : G;
                if (bx < gg) { pg8::Gemm g{Hb, FUP_T, M, 2 * FFD, D, 0}; pg8::StaticOrder S; S.init(M, 2 * FFD, gg, bx); pg8::EpiSwiglu E{GBUF, FFD, 0, 0}; pg8::gemm_phase(lds, g, S, E, tz, ctl + CW_DONE(2)); }
                else conv_run(args.in[I_M1], args.in[I_M3], args.in[I_M2], MUP_T, MDN_T, ctl, MISC + 16, true, ctl + CW_DONE(2), 16u, 1 << 30, 1); }
            else { const int nT = __builtin_amdgcn_readfirstlane(TILEE[127]);
                const int gg = (G == 256) ? 238 : G;
                if (bx < gg) { pg8::Gemm g{HPERM, MUP_T, nT * 256, 2 * FFE, D, (size_t)2 * FFE * D * 2}; pg8::MoeOrder S; S.init(nT, 2 * FFE, gg, bx, TILEE); pg8::EpiSwiglu E{GBUF, FFE / 2, 28, (size_t)MAXPT * 256 * (FFE / 2)};
                    pg8::gemm_phase(lds, g, S, E, tz, ctl + CW_DONE(10)); }
                else conv_run(args.in[I_M1], args.in[I_M3], args.in[I_M2], MUP_T, MDN_T, ctl, MISC + 16, true, ctl + CW_DONE(10), 16u, 1 << 30, 1);
                __syncthreads();
                conv_run(args.in[I_M1], args.in[I_M3], args.in[I_M2], MUP_T, MDN_T, ctl, MISC + 16, true, nullptr, 0u, 1 << 30); }
        }
        SEAM(pb + 8);
        if (EN(10) && IN(pb + 9)) {
            int tz = threadIdx.x; asm volatile("" : "+v"(tz)); const int lane = tz & 63; const int wave = __builtin_amdgcn_readfirstlane(tz >> 6); const int tid = tz; const int gw = bx * NWAVES + wave; (void)lane; (void)tid; (void)gw;
            if (layer == 0) { pg8::Gemm g{GBUF, FDN_T, M, D, FFD, 0}; pg8::StaticOrder S; S.init(M, D, G, bx); pg8::EpiResid E{XA, XA}; pg8::gemm_phase(lds, g, S, E, tz); }
            else { const int nT = __builtin_amdgcn_readfirstlane(TILEE[127]);
                pg8::Gemm g{GBUF, MDN_T, 2 * MAXPT * 256, D, FFE / 2, (size_t)D * (FFE / 2) * 2}; pg8::MoeDownOrder S; S.init(nT, D, G, bx, TILEE); pg8::EpiMoeDown E{YPERM, HPERM}; pg8::gemm_phase(lds, g, S, E, tz); }
        }
        SEAM(pb + 9);
        if (EN(11) && IN(pb + 10)) {
            int tz = threadIdx.x; asm volatile("" : "+v"(tz)); const int lane = tz & 63; const int wave = __builtin_amdgcn_readfirstlane(tz >> 6); const int tid = tz; const int gw = bx * NWAVES + wave; (void)lane; (void)tid; (void)gw;
            if (layer == 0) { for (int m = gw; m < M; m += ngw) rms_row_to_bf16(XA + (size_t)m * D, args.in[I_NMIX] + D, Hb + (size_t)m * D, lane); }
            else {
                for (int m = gw; m < M; m += ngw) {
                    const int p0 = TOKP[2 * m], p1 = TOKP[2 * m + 1]; const float g0 = TOKW[2 * m], g1 = TOKW[2 * m + 1];
                    const f32x4* xr = (const f32x4*)(XA + (size_t)m * D) + lane; const v2u* y0 = (const v2u*)(YPERM + (size_t)p0 * D) + lane; const v2u* y1 = (const v2u*)(YPERM + (size_t)p1 * D) + lane;
                    const v2u* z0 = (const v2u*)(HPERM + (size_t)p0 * D) + lane; const v2u* z1 = (const v2u*)(HPERM + (size_t)p1 * D) + lane;
                    f32x4 v[8]; float s = 0.f;
#pragma unroll
                    for (int jj = 0; jj < 8; ++jj) { const v2u a = y0[64 * jj], c = y1[64 * jj], a2 = z0[64 * jj], c2 = z1[64 * jj]; f32x4 x = xr[64 * jj];
                        x.x += g0 * (bflo(a.x) + bflo(a2.x)) + g1 * (bflo(c.x) + bflo(c2.x)); x.y += g0 * (bfhi(a.x) + bfhi(a2.x)) + g1 * (bfhi(c.x) + bfhi(c2.x));
                        x.z += g0 * (bflo(a.y) + bflo(a2.y)) + g1 * (bflo(c.y) + bflo(c2.y)); x.w += g0 * (bfhi(a.y) + bfhi(a2.y)) + g1 * (bfhi(c.y) + bfhi(c2.y));
                        v[jj] = x; s += (x.x * x.x + x.y * x.y) + (x.z * x.z + x.w * x.w); }
                    const float rstd = 1.0f / sqrtf(wave_sum(s) * (1.0f / D) + EPS);
                    const f32x4* gr = (const f32x4*)args.in[I_NF] + lane; f32x4* orow = (f32x4*)(args.out + (size_t)m * D) + lane;
#pragma unroll
                    for (int jj = 0; jj < 8; ++jj) { const f32x4 gg = gr[64 * jj]; orow[64 * jj] = (f32x4){v[jj].x * rstd * gg.x, v[jj].y * rstd * gg.y, v[jj].z * rstd * gg.z, v[jj].w * rstd * gg.w}; }
                }
            }
        }
        SEAM(pb + 10);
    }
#undef IN
#undef SEAM
}

constexpr int N_PHASES = 23;
extern "C" void kernel_launch(void* const* d_in, const int* in_sizes, int n_in, void* d_out, int out_size, void* d_ws, size_t ws_size, hipStream_t stream) {
    static int grid = 0;
    if (grid == 0) {
        if (n_in != 26 || out_size != M * D || ws_size < WS_END) { fprintf(stderr, "kernel_launch: unexpected shapes: n_in %d out %d ws %zu (need %zu)\n", n_in, out_size, ws_size, (size_t)WS_END); grid = -1; return; }
        int dev = 0, cus = 0, per_cu = 0;
        if (hipGetDevice(&dev) != hipSuccess || hipDeviceGetAttribute(&cus, hipDeviceAttributeMultiprocessorCount, dev) != hipSuccess) { grid = -1; return; }
        if (hipFuncSetAttribute((const void*)trunk_fwd, hipFuncAttributeMaxDynamicSharedMemorySize, LDS_BYTES) != hipSuccess) { fprintf(stderr, "kernel_launch: hipFuncSetAttribute failed\n"); grid = -1; return; }
        if (hipOccupancyMaxActiveBlocksPerMultiprocessor(&per_cu, (const void*)trunk_fwd, NWAVES * 64, LDS_BYTES) != hipSuccess || per_cu < 1) { fprintf(stderr, "kernel_launch: occupancy query says %d\n", per_cu); }
        (void)hipGetLastError();
        grid = cus;
    }
    if (grid < 0) return;
    (void)hipMemsetAsync((char*)d_ws + WS_CTL, 0, 65536, stream);
    Args a{};
    for (int i = 0; i < 26; ++i) a.in[i] = (const float*)d_in[i];
    a.out = (float*)d_out; a.ws = (unsigned char*)d_ws;
#if MK_PER_PHASE
    for (int p = 0; p < N_PHASES; ++p) { a.ph_lo = p; a.ph_hi = p + 1; hipLaunchKernelGGL(trunk_fwd, dim3(grid), dim3(NWAVES * 64), LDS_BYTES, stream, a); }
#else
    a.ph_lo = 0; a.ph_hi = N_PHASES;
    hipLaunchKernelGGL(trunk_fwd, dim3(grid), dim3(NWAVES * 64), LDS_BYTES, stream, a);
#endif
}
```
